# Optimizing an MI355X kernel written in HIP

```python
import math
import numpy as np
import jax, jax.numpy as jnp
from jax import lax

D_MODEL = 1024
BATCH = 2
SEQ = 8192
DEPTH = 2

GRID_W = 64
MEM_LEN = 256
HEAD_DIM = 64
DA_HEADS = 4
DA_VDIM = 2 * HEAD_DIM
DA_QK = DA_HEADS * 2 * HEAD_DIM
DA_V = DA_HEADS * DA_VDIM
Q_BLOCK = 128
NA_HEADS = 8
NA_W = NA_HEADS * HEAD_DIM
NA_WIN_ROWS = 8
NA_WIN_COLS = 16
NA_QCOLS = 16
NA_KCOLS = 32
SC_W = 512
SC_K = 3
N_BRANCH = 3
BRANCH_W = 512
IN_SPLITS = (DA_QK, DA_QK, DA_V, NA_W, NA_W, NA_W, SC_W, SC_W, SC_W, N_BRANCH * D_MODEL)
IN_COLS = 7680
XA_HEADS = 4
XA_DIM = D_MODEL // XA_HEADS
D_FF = 2816
FFN_K = 3
ROPE_THETA = 10000.0
LN_EPS = 1e-5

kernel_name = 'hybrid_diff_natten_shortconv_encoder'


def layer_norm(x, g, b):
    xf = x.astype(jnp.float32)
    mu = jnp.mean(xf, axis=-1, keepdims=True)
    var = jnp.mean(jnp.square(xf - mu), axis=-1, keepdims=True)
    y = (xf - mu) * lax.rsqrt(var + LN_EPS)
    return (y * g.astype(jnp.float32) + b.astype(jnp.float32)).astype(x.dtype)


def rms_norm(x, g):
    xf = x.astype(jnp.float32)
    y = xf * lax.rsqrt(jnp.mean(jnp.square(xf), axis=-1, keepdims=True) + LN_EPS)
    return (y * g.astype(jnp.float32)).astype(x.dtype)


def rope(x, pos):
    d = x.shape[-1]
    half = d // 2
    inv = ROPE_THETA ** (-jnp.arange(half, dtype=jnp.float32) * 2.0 / d)
    ang = pos.astype(jnp.float32)[:, None] * inv[None, :]
    cos = jnp.cos(ang).astype(x.dtype)
    sin = jnp.sin(ang).astype(x.dtype)
    x1, x2 = x[..., :half], x[..., half:]
    return jnp.concatenate([x1 * cos - x2 * sin, x2 * cos + x1 * sin], axis=-1)


def dwconv(x, w):
    k, c = w.shape
    return lax.conv_general_dilated(x, w[:, None, :], window_strides=(1,), padding=[(k // 2, k // 2)],
                                    dimension_numbers=('NWC', 'WIO', 'NWC'), feature_group_count=c)


def diff_attention(q, k, v, lam, pos):
    b, s = q.shape[0], q.shape[1]
    q = rope(q.transpose(0, 2, 3, 1, 4), pos) * (HEAD_DIM ** -0.5)
    k = rope(k.transpose(0, 2, 3, 1, 4), pos)
    vt = v.transpose(0, 2, 1, 3)
    nb = s // Q_BLOCK
    qb = q.reshape(b, DA_HEADS, 2, nb, Q_BLOCK, HEAD_DIM).transpose(3, 0, 1, 2, 4, 5)

    def block(qblk):
        sc = jnp.einsum('bhmqd,bhmkd->bhmqk', qblk, k, preferred_element_type=jnp.float32)
        p = jax.nn.softmax(sc, axis=-1)
        w = p[:, :, 0] - lam * p[:, :, 1]
        return jnp.einsum('bhqk,bhkv->bhqv', w.astype(vt.dtype), vt)

    o = lax.map(block, qb)
    return o.transpose(1, 2, 0, 3, 4).reshape(b, DA_HEADS, s, DA_VDIM)


def _na_static(rows):
    wr = min(NA_WIN_ROWS, rows)
    n_cb = GRID_W // NA_QCOLS
    c = np.arange(GRID_W).reshape(n_cb, NA_QCOLS)
    cs = np.clip(c - NA_WIN_COLS // 2, 0, GRID_W - NA_WIN_COLS)
    kstart = np.minimum(cs[:, 0], GRID_W - NA_KCOLS)
    kcol = kstart[:, None] + np.arange(NA_KCOLS)
    rel = kcol[:, None, :] - c[:, :, None]
    valid = (kcol[:, None, :] >= cs[:, :, None]) & (kcol[:, None, :] < cs[:, :, None] + NA_WIN_COLS)
    dc_idx = np.clip(rel + NA_WIN_COLS - 1, 0, 2 * NA_WIN_COLS - 2)
    return wr, n_cb, kcol.astype(np.int32), dc_idx.astype(np.int32), valid


def neighbourhood_attention(q, k, v, rpb):
    b, s = q.shape[0], q.shape[1]
    rows = s // GRID_W
    wr, n_cb, kcol, dc_idx, valid = _na_static(rows)

    def grid(t):
        return t.reshape(b, rows, GRID_W, NA_HEADS, HEAD_DIM).transpose(0, 3, 1, 2, 4)

    qg = grid(q) * (HEAD_DIM ** -0.5)
    kg = grid(k)
    vg = grid(v)
    qr = qg.reshape(b, NA_HEADS, rows, n_cb, NA_QCOLS, HEAD_DIM).transpose(2, 0, 1, 3, 4, 5)
    kcol_j = jnp.asarray(kcol)
    mask = jnp.asarray(valid)[:, :, None, :]
    bias_c = rpb[:, :, jnp.asarray(dc_idx)]

    def row_block(args):
        r, qblk = args
        rs = jnp.clip(r - wr // 2, 0, rows - wr)
        k_rows = lax.dynamic_slice_in_dim(kg, rs, wr, axis=2)
        v_rows = lax.dynamic_slice_in_dim(vg, rs, wr, axis=2)
        k_blk = jnp.take(k_rows, kcol_j, axis=3)
        v_blk = jnp.take(v_rows, kcol_j, axis=3)
        sc = jnp.einsum('bhjqd,bhrjkd->bhjqrk', qblk, k_blk, preferred_element_type=jnp.float32)
        dr_idx = rs + jnp.arange(wr) - r + (NA_WIN_ROWS - 1)
        bias = jnp.take(bias_c, dr_idx, axis=1).transpose(0, 2, 3, 1, 4)
        sc = jnp.where(mask, sc + bias[None].astype(jnp.float32), -jnp.inf)
        p = jax.nn.softmax(sc.reshape(sc.shape[:4] + (wr * NA_KCOLS,)), axis=-1).reshape(sc.shape)
        return jnp.einsum('bhjqrk,bhrjkd->bhjqd', p.astype(v_blk.dtype), v_blk)

    o = lax.map(row_block, (jnp.arange(rows, dtype=jnp.int32), qr))
    return o.transpose(1, 0, 3, 4, 2, 5).reshape(b, s, NA_W)


def hybrid_mixer(x, w_in, lam_q1, lam_k1, lam_q2, lam_k2, subln_g, rpb, sc_conv_w, w_branch, w_mix_out, lam_init, pos):
    b, s, _ = x.shape
    proj = x @ w_in
    qa, ka, va, qb, kb, vb, gb, gc, hc, gates = jnp.split(proj, np.cumsum(IN_SPLITS)[:-1].tolist(), axis=-1)
    lam = (jnp.exp(jnp.sum(lam_q1.astype(jnp.float32) * lam_k1.astype(jnp.float32)))
           - jnp.exp(jnp.sum(lam_q2.astype(jnp.float32) * lam_k2.astype(jnp.float32))) + lam_init)
    oa = diff_attention(qa.reshape(b, s, DA_HEADS, 2, HEAD_DIM), ka.reshape(b, s, DA_HEADS, 2, HEAD_DIM),
                        va.reshape(b, s, DA_HEADS, DA_VDIM), lam, pos)
    ya = (rms_norm(oa, subln_g) * (1.0 - lam_init)).transpose(0, 2, 1, 3).reshape(b, s, DA_V)
    yb = neighbourhood_attention(qb, kb, vb, rpb)
    yc = gb * dwconv(gc * hc, sc_conv_w)
    g = jax.nn.sigmoid(gates.reshape(b, s, N_BRANCH, D_MODEL))
    merged = (g[:, :, 0] * (ya @ w_branch[0]) + g[:, :, 1] * (yb @ w_branch[1])
              + g[:, :, 2] * (yc @ w_branch[2]))
    return merged @ w_mix_out


def memory_cross_attention(x, mem, xa_q, xa_kv, xa_o):
    b, s, _ = x.shape
    q = (x @ xa_q).reshape(b, s, XA_HEADS, XA_DIM) * (XA_DIM ** -0.5)
    k, v = jnp.split(mem @ xa_kv, 2, axis=-1)
    k = k.reshape(b, mem.shape[1], XA_HEADS, XA_DIM)
    v = v.reshape(b, mem.shape[1], XA_HEADS, XA_DIM)
    p = jax.nn.softmax(jnp.einsum('bqhd,bkhd->bhqk', q, k, preferred_element_type=jnp.float32), axis=-1)
    o = jnp.einsum('bhqk,bkhd->bqhd', p.astype(v.dtype), v).reshape(b, s, D_MODEL)
    return o @ xa_o


def conv_ffn(x, ffn_w_in, ffn_conv_w, ffn_conv_b, ffn_w_out):
    u, gt = jnp.split(x @ ffn_w_in, 2, axis=-1)
    a = dwconv(gt, ffn_conv_w) + ffn_conv_b
    return (jax.nn.silu(a) * u) @ ffn_w_out


def setup_inputs(seed: int = 0) -> dict:
    key = jax.random.key(seed)
    ks = jax.random.split(key, 24)
    beta = (8.0 * DEPTH) ** -0.25

    def nrm(k, shape, scale):
        return jax.random.normal(k, shape, jnp.float32) * scale

    is_value = (False, False, True, False, False, True, False, False, True, False)
    col_scale = np.concatenate([np.full(n, beta if iv else 1.0, np.float32) for n, iv in zip(IN_SPLITS, is_value)])
    kv_scale = np.concatenate([np.ones(D_MODEL, np.float32), np.full(D_MODEL, beta, np.float32)])
    return {
        'x': nrm(ks[0], (BATCH, SEQ, D_MODEL), 1.0),
        'mem': nrm(ks[1], (BATCH, MEM_LEN, D_MODEL), 1.0),
        'emb_ln_g': 1.0 + nrm(ks[2], (D_MODEL,), 0.02),
        'emb_ln_b': nrm(ks[3], (D_MODEL,), 0.02),
        'w_in': nrm(ks[4], (DEPTH, D_MODEL, IN_COLS), D_MODEL ** -0.5) * jnp.asarray(col_scale),
        'lam_q1': nrm(ks[5], (DEPTH, HEAD_DIM), 0.1),
        'lam_k1': nrm(ks[6], (DEPTH, HEAD_DIM), 0.1),
        'lam_q2': nrm(ks[7], (DEPTH, HEAD_DIM), 0.1),
        'lam_k2': nrm(ks[8], (DEPTH, HEAD_DIM), 0.1),
        'subln_g': 1.0 + nrm(ks[9], (DEPTH, DA_VDIM), 0.02),
        'rpb': nrm(ks[10], (DEPTH, NA_HEADS, 2 * NA_WIN_ROWS - 1, 2 * NA_WIN_COLS - 1), 0.1),
        'sc_conv_w': nrm(ks[11], (DEPTH, SC_K, SC_W), SC_K ** -0.5),
        'w_branch': nrm(ks[12], (DEPTH, N_BRANCH, BRANCH_W, D_MODEL), BRANCH_W ** -0.5 * beta),
        'w_mix_out': nrm(ks[13], (DEPTH, D_MODEL, D_MODEL), D_MODEL ** -0.5 * beta),
        'xa_q': nrm(ks[14], (DEPTH, D_MODEL, D_MODEL), D_MODEL ** -0.5),
        'xa_kv': nrm(ks[15], (DEPTH, D_MODEL, 2 * D_MODEL), D_MODEL ** -0.5) * jnp.asarray(kv_scale),
        'xa_o': nrm(ks[16], (DEPTH, D_MODEL, D_MODEL), D_MODEL ** -0.5 * beta),
        'ffn_w_in': nrm(ks[17], (DEPTH, D_MODEL, 2 * D_FF), D_MODEL ** -0.5 * beta),
        'ffn_conv_w': nrm(ks[18], (DEPTH, FFN_K, D_FF), FFN_K ** -0.5),
        'ffn_conv_b': nrm(ks[19], (DEPTH, D_FF), 0.02),
        'ffn_w_out': nrm(ks[20], (DEPTH, D_FF, D_MODEL), D_FF ** -0.5 * beta),
        'ln_g': 1.0 + nrm(ks[21], (DEPTH, 3, D_MODEL), 0.02),
        'ln_b': nrm(ks[22], (DEPTH, 3, D_MODEL), 0.02),
    }


def reference(x, mem, emb_ln_g, emb_ln_b, w_in, lam_q1, lam_k1, lam_q2, lam_k2, subln_g, rpb, sc_conv_w,
              w_branch, w_mix_out, xa_q, xa_kv, xa_o, ffn_w_in, ffn_conv_w, ffn_conv_b, ffn_w_out, ln_g, ln_b):
    alpha = (2.0 * DEPTH) ** 0.25
    pos = jnp.arange(x.shape[1], dtype=jnp.int32)
    x = layer_norm(x, emb_ln_g, emb_ln_b)
    for l in range(DEPTH):
        lam_init = 0.8 - 0.6 * math.exp(-0.3 * l)
        h = hybrid_mixer(x, w_in[l], lam_q1[l], lam_k1[l], lam_q2[l], lam_k2[l], subln_g[l], rpb[l],
                         sc_conv_w[l], w_branch[l], w_mix_out[l], lam_init, pos)
        x = layer_norm(alpha * x + h, ln_g[l, 0], ln_b[l, 0])
        h = memory_cross_attention(x, mem, xa_q[l], xa_kv[l], xa_o[l])
        x = layer_norm(alpha * x + h, ln_g[l, 1], ln_b[l, 1])
        h = conv_ffn(x, ffn_w_in[l], ffn_conv_w[l], ffn_conv_b[l], ffn_w_out[l])
        x = layer_norm(alpha * x + h, ln_g[l, 2], ln_b[l, 2])
    return x
```

```cpp
#include <hip/hip_runtime.h>
#include <stdint.h>
#include <stdio.h>

#ifndef MK_PER_PHASE
#define MK_PER_PHASE 0
#endif

#define LAS __attribute__((address_space(3)))
#define GAS __attribute__((address_space(1)))
typedef _Float16 h8 __attribute__((ext_vector_type(8)));
typedef _Float16 h4 __attribute__((ext_vector_type(4)));
typedef _Float16 h2 __attribute__((ext_vector_type(2)));
typedef float f32x2 __attribute__((ext_vector_type(2)));
typedef float f32x4 __attribute__((ext_vector_type(4)));
typedef float f32x16 __attribute__((ext_vector_type(16)));
typedef unsigned u32x2 __attribute__((ext_vector_type(2)));
typedef unsigned u32x4 __attribute__((ext_vector_type(4)));
typedef short s16x4 __attribute__((ext_vector_type(4)));
typedef short s16x8 __attribute__((ext_vector_type(8)));
typedef GAS unsigned gu32;

constexpr int NB = 2, SEQ = 8192, DM = 1024, MTOK = NB * SEQ, NLAYER = 2;
constexpr int DFF = 2816, INCOLS = 7680;
constexpr float LN_EPS = 1e-5f, ALPHA = 1.41421356237309515f, LOG2E = 1.44269504088896341f;
constexpr int NWAVES = 8, NTHREADS = 512;

constexpr size_t MiB = (size_t)1 << 20;
constexpr size_t WS_CTL = 0, CTL_ZERO_BYTES = 1 * MiB;
constexpr size_t WS_CS = 1 * MiB;
constexpr size_t WS_MEMH = 3 * MiB;
constexpr size_t WS_KX = 4 * MiB;
constexpr size_t WS_VT = 5 * MiB;
constexpr size_t WS_MISC = 6 * MiB;
constexpr size_t WS_WF1 = 8 * MiB;
constexpr size_t WS_WF2 = 19 * MiB;
constexpr size_t WS_XH = 25 * MiB;
constexpr size_t WS_WINA = 57 * MiB;
constexpr size_t WS_WG = 66 * MiB;
constexpr size_t WS_WBR = 72 * MiB;
constexpr size_t WS_WMIX = 75 * MiB, WS_WXQ = 77 * MiB, WS_WXK = 79 * MiB, WS_WXV = 81 * MiB, WS_WXO = 83 * MiB;
constexpr size_t WS_QA = 85 * MiB, WS_QB = 101 * MiB, WS_GB = 117 * MiB, WS_KA = 133 * MiB, WS_VA = 149 * MiB, WS_KB = 165 * MiB, WS_VB = 181 * MiB, WS_GCHC = 197 * MiB;
constexpr size_t WS_STASH = 213 * MiB;
constexpr size_t WS_GS = 133 * MiB, WS_MG = 165 * MiB;
constexpr size_t WS_QX = 85 * MiB, WS_PX = 117 * MiB, WS_OX = 149 * MiB;
constexpr size_t WS_UG = 57 * MiB;
constexpr size_t WS_END = 245 * MiB;
constexpr int CW_BAR = 4096;

constexpr int RING_BYTES = 131072;
constexpr int LDSCTL_OFF = RING_BYTES, MISC_OFF = LDSCTL_OFF + 320;
constexpr int LDS_BYTES = 147456;

#define RLX_AGENT __ATOMIC_RELAXED, __HIP_MEMORY_SCOPE_AGENT
#define LDS_WAIT() asm volatile("s_waitcnt lgkmcnt(0)" ::: "memory")
#define VM_WAIT() asm volatile("s_waitcnt vmcnt(0)" ::: "memory")

__device__ __forceinline__ unsigned pkh(float lo, float hi) { h2 v = {(_Float16)lo, (_Float16)hi}; return __builtin_bit_cast(unsigned, v); }
__device__ __forceinline__ u32x4 pk8(f32x4 a, f32x4 b) { u32x4 w; w.x = pkh(a[0], a[1]); w.y = pkh(a[2], a[3]); w.z = pkh(b[0], b[1]); w.w = pkh(b[2], b[3]); return w; }
__device__ __forceinline__ void unpk8(u32x4 w, f32x4& a, f32x4& b) {
    const h8 v = __builtin_bit_cast(h8, w);
    a = (f32x4){(float)v[0], (float)v[1], (float)v[2], (float)v[3]}; b = (f32x4){(float)v[4], (float)v[5], (float)v[6], (float)v[7]}; }
__device__ __forceinline__ float wave_sum(float v) {
#pragma unroll
    for (int o = 1; o < 64; o <<= 1) v += __shfl_xor(v, o);
    return v; }

struct Params { const float* in[23]; float* out; unsigned char* ws; int ph_lo, ph_hi; };
struct Frame {
    LAS unsigned char* lds;
    unsigned char* ws;
    float* X32;
    int wave, vcu, G;
};
__device__ __forceinline__ int opaque_tid() { int t = threadIdx.x; asm volatile("" : "+v"(t)); return t; }
template <int I> __device__ __forceinline__ const float* inptr() {
    unsigned long long v; auto ka = __builtin_amdgcn_kernarg_segment_ptr();
    asm volatile("s_load_dwordx2 %0, %1, %2\n\ts_waitcnt lgkmcnt(0)" : "=s"(v) : "s"(ka), "i"(I * 8) : "memory");
    return (const float*)v;
}
enum { I_X = 0, I_MEM, I_EMBG, I_EMBB, I_WIN, I_LQ1, I_LK1, I_LQ2, I_LK2, I_SUBG, I_RPB, I_SCW, I_WBR, I_WMIX, I_XAQ, I_XAKV, I_XAO, I_FW1, I_FCW, I_FCB, I_FW2, I_LNG, I_LNB };

namespace g8 {
constexpr int BM = 256, BK = 64, HALF = 128, HTB = HALF * BK * 2, STAGE_BYTES = 8 * HTB, NXCD = 8, WGM = 8;
__device__ __forceinline__ int lds_byte(int r, int c) { const int st = (r >> 4) * 2 + (c >> 5), rr = r & 15, cc = c & 31, ob = rr * 64 + cc * 2; return st * 1024 + (ob ^ (((ob >> 9) & 1) << 5)); }
__device__ __forceinline__ void stage_rc(int b, int& R, int& C) { const int st = b / 1024, sb = b % 1024, swz = sb ^ (((sb >> 9) & 1) << 5); R = (st >> 1) * 16 + swz / 64; C = (st & 1) * 32 + (swz % 64) / 2; }
__device__ __forceinline__ int perm32(int rho) { const int n = rho >> 4, i = rho & 15; return 8 * (i >> 2) + 4 * n + (i & 3); }
struct Unit { unsigned A, B; int pa, pb, nt, pm, pn, sub; };
__device__ __forceinline__ bool tile_map(int L, int nM, int nN, int& pm, int& pn) {
    const int nwg = nM * nN; if (L >= nwg) return false;
    int wgid = L; { const int q = nwg / NXCD, r = nwg % NXCD, xcd = wgid % NXCD, off = wgid / NXCD; wgid = (xcd < r ? xcd * (q + 1) : r * (q + 1) + (xcd - r) * q) + off; }
    const int nig = WGM * nN, gid = wgid / nig, fm = gid * WGM, gsz = (nM - fm) < WGM ? (nM - fm) : WGM;
    pm = fm + ((wgid % nig) % gsz); pn = (wgid % nig) / gsz; return true;
}
}

enum GemmKind { GK_A = 0, GK_C12, GK_C3, GK_D1, GK_D2, GK_D3, GK_D4, GK_E1, GK_E3 };

__device__ __forceinline__ bool gemm_sched(const Frame& F, int gk, int i, g8::Unit& u) {
    const int c = blockIdx.x, G = F.G;
    u.sub = 0;
    switch (gk) {
    case GK_A: {
        const int L = i * G + c;
        if (L < 64 * 18) { g8::tile_map(L, 64, 18, u.pm, u.pn); u.A = (unsigned)(WS_XH + (size_t)u.pm * 256 * 2048); u.B = (unsigned)(WS_WINA + (size_t)u.pn * 256 * 2048); u.pa = 2048; u.pb = 2048; u.nt = 16; return true; }
        const int idx = L - 64 * 18; if (idx >= 16) return false;
        if (idx < 8) { u.pm = idx >> 2; u.pn = idx & 3; u.sub = 1; u.A = (unsigned)(WS_MEMH + (size_t)u.pm * 256 * 2048); u.B = (unsigned)(WS_WXK + (size_t)u.pn * 256 * 2048); }
        else { const int j = idx - 8; u.pm = j >> 1; u.pn = j & 1; u.sub = 2; u.A = (unsigned)(WS_WXV + (size_t)u.pm * 256 * 2048); u.B = (unsigned)(WS_MEMH + (size_t)u.pn * 256 * 2048); }
        u.pa = 2048; u.pb = 2048; u.nt = 16; return true; }
    case GK_C12: {
        const int ti = i / 6, sub = i % 6; if (!g8::tile_map(ti * G + c, 64, 4, u.pm, u.pn)) return false;
        u.sub = sub; const int br = sub >> 1;
        if ((sub & 1) == 0) { u.A = (unsigned)(WS_XH + (size_t)u.pm * 256 * 2048); u.B = (unsigned)(WS_WG + (size_t)(br * 1024 + u.pn * 256) * 2048); u.pa = 2048; u.pb = 2048; u.nt = 16; }
        else { const size_t yb = br == 0 ? WS_QA : (br == 1 ? WS_QB : WS_GB);
            u.A = (unsigned)(yb + (size_t)u.pm * 256 * 1024); u.B = (unsigned)(WS_WBR + (size_t)br * (1024 * 512 * 2) + (size_t)u.pn * 256 * 1024); u.pa = 1024; u.pb = 1024; u.nt = 8; }
        return true; }
    case GK_C3: case GK_D1: case GK_D4: {
        if (!g8::tile_map(i * G + c, 64, 4, u.pm, u.pn)) return false;
        const size_t a = gk == GK_C3 ? WS_MG : (gk == GK_D1 ? WS_XH : WS_OX), b = gk == GK_C3 ? WS_WMIX : (gk == GK_D1 ? WS_WXQ : WS_WXO);
        u.A = (unsigned)(a + (size_t)u.pm * 256 * 2048); u.B = (unsigned)(b + (size_t)u.pn * 256 * 2048); u.pa = 2048; u.pb = 2048; u.nt = 16; return true; }
    case GK_D2: {
        if (!g8::tile_map(i * G + c, 64, 4, u.pm, u.pn)) return false;
        const int b = u.pm >> 5, h = u.pn;
        u.A = (unsigned)(WS_QX + (size_t)u.pm * 256 * 2048 + h * 512); u.B = (unsigned)(WS_KX + (size_t)b * 256 * 2048 + h * 512); u.pa = 2048; u.pb = 2048; u.nt = 4; return true; }
    case GK_D3: {
        if (!g8::tile_map(i * G + c, 64, 4, u.pm, u.pn)) return false;
        const int b = u.pm >> 5, h = u.pn;
        u.A = (unsigned)(WS_PX + (size_t)u.pm * 256 * 2048 + h * 512); u.B = (unsigned)(WS_VT + (size_t)h * 256 * 1024 + b * 512); u.pa = 2048; u.pb = 1024; u.nt = 4; return true; }
    case GK_E1: {
        if (!g8::tile_map(i * G + c, 64, 22, u.pm, u.pn)) return false;
        u.A = (unsigned)(WS_XH + (size_t)u.pm * 256 * 2048); u.B = (unsigned)(WS_WF1 + (size_t)u.pn * 256 * 2048); u.pa = 2048; u.pb = 2048; u.nt = 16; return true; }
    case GK_E3: {
        if (!g8::tile_map(i * G + c, 64, 4, u.pm, u.pn)) return false;
        u.A = (unsigned)(WS_UG + (size_t)u.pm * 256 * (5632 * 2)); u.B = (unsigned)(WS_WF2 + (size_t)u.pn * 256 * (2816 * 2)); u.pa = 5632 * 2; u.pb = 2816 * 2; u.nt = 44; return true; }
    }
    return false;
}

typedef f32x4 Acc[2][2][4][2];
__device__ __forceinline__ float sigmoidf_(float x) { return __builtin_amdgcn_rcpf(1.0f + __builtin_amdgcn_exp2f(-LOG2E * x)); }

__device__ __forceinline__ void store_plain16(const Acc& acc, _Float16* dst, int ldc, int row0, int col0, float sc, int wr, int wc, int fr, int fq) {
#pragma unroll
    for (int ai = 0; ai < 2; ++ai)
#pragma unroll
        for (int m = 0; m < 4; ++m) { _Float16* rp = dst + (size_t)(row0 + ai * 128 + wr * 64 + m * 16 + fr) * ldc + col0 + wc * 32 + 8 * fq;
#pragma unroll
            for (int bj = 0; bj < 2; ++bj) *(u32x4*)(rp + bj * 128) = pk8(acc[ai][bj][m][0] * sc, acc[ai][bj][m][1] * sc); }
}

__device__ __forceinline__ void gemm_epilogue(const Frame& F, int gk, int layer, const g8::Unit& u, Acc& acc, int wr, int wc, int fr, int fq) {
    unsigned char* ws = F.ws;
    const int row0 = u.pm * 256;
    switch (gk) {
    case GK_A: {
        if (u.sub == 1) { store_plain16(acc, (_Float16*)(ws + WS_KX), 1024, row0, u.pn * 256, 1.0f, wr, wc, fr, fq); return; }
        if (u.sub == 2) { store_plain16(acc, (_Float16*)(ws + WS_VT), 512, row0, u.pn * 256, 1.0f, wr, wc, fr, fq); return; }
        const int pn = u.pn;
        if (pn < 4) {
            _Float16* dst = (_Float16*)(ws + (pn < 2 ? WS_QA : WS_KA)); const float sc = pn < 2 ? 0.125f * LOG2E : 1.0f; const int cb = (pn & 1) * 256;
            const f32x4* cs = (const f32x4*)(ws + WS_CS);
            const int i0 = 16 * (wc & 1) + 4 * fq;
#pragma unroll
            for (int ai = 0; ai < 2; ++ai)
#pragma unroll
                for (int m = 0; m < 4; ++m) { const int row = row0 + ai * 128 + wr * 64 + m * 16 + fr, pos = row & (SEQ - 1);
                    const f32x4 t0 = cs[(pos * 32 + i0) / 2], t1 = cs[(pos * 32 + i0) / 2 + 1];
                    _Float16* rp = dst + (size_t)row * 512 + cb + wc * 32 + 8 * fq;
#pragma unroll
                    for (int bj = 0; bj < 2; ++bj) { const f32x4 a = acc[ai][bj][m][0], b = acc[ai][bj][m][1]; f32x4 oa, ob;
                        oa[0] = (a[0] * t0[0] - a[1] * t0[1]) * sc; oa[1] = (a[1] * t0[0] + a[0] * t0[1]) * sc; oa[2] = (a[2] * t0[2] - a[3] * t0[3]) * sc; oa[3] = (a[3] * t0[2] + a[2] * t0[3]) * sc;
                        ob[0] = (b[0] * t1[0] - b[1] * t1[1]) * sc; ob[1] = (b[1] * t1[0] + b[0] * t1[1]) * sc; ob[2] = (b[2] * t1[2] - b[3] * t1[3]) * sc; ob[3] = (b[3] * t1[2] + b[2] * t1[3]) * sc;
                        *(u32x4*)(rp + bj * 128) = pk8(oa, ob); } }
            return; }
        if (pn < 14) {
            const int t = (pn - 4) >> 1; const size_t off = t == 0 ? WS_VA : t == 1 ? WS_QB : t == 2 ? WS_KB : t == 3 ? WS_VB : WS_GB;
            store_plain16(acc, (_Float16*)(ws + off), 512, row0, (pn & 1) * 256, t == 1 ? 0.125f * LOG2E : 1.0f, wr, wc, fr, fq); return; }
        {
            _Float16* dst = (_Float16*)(ws + WS_GCHC); const int uu = pn - 14;
#pragma unroll
            for (int ai = 0; ai < 2; ++ai)
#pragma unroll
                for (int m = 0; m < 4; ++m) { const int row = row0 + ai * 128 + wr * 64 + m * 16 + fr;
                    *(u32x4*)(dst + (size_t)row * 512 + uu * 128 + wc * 32 + 8 * fq) = pk8(acc[ai][0][m][0] * acc[ai][1][m][0], acc[ai][0][m][1] * acc[ai][1][m][1]); }
        }
        return; }
    case GK_C12: {
        _Float16* gs = (_Float16*)(ws + WS_GS); _Float16* mg = (_Float16*)(ws + WS_MG);
        if ((u.sub & 1) == 0) {
#pragma unroll
            for (int ai = 0; ai < 2; ++ai)
#pragma unroll
                for (int m = 0; m < 4; ++m) { const int row = row0 + ai * 128 + wr * 64 + m * 16 + fr; _Float16* rp = gs + (size_t)row * 1024 + u.pn * 256 + wc * 32 + 8 * fq;
#pragma unroll
                    for (int bj = 0; bj < 2; ++bj) { f32x4 a = acc[ai][bj][m][0], b = acc[ai][bj][m][1];
#pragma unroll
                        for (int e = 0; e < 4; ++e) { a[e] = sigmoidf_(a[e]); b[e] = sigmoidf_(b[e]); }
                        *(u32x4*)(rp + bj * 128) = pk8(a, b); } }
        } else {
            const bool first = u.sub == 1;
#pragma unroll
            for (int ai = 0; ai < 2; ++ai)
#pragma unroll
                for (int m = 0; m < 4; ++m) { const int row = row0 + ai * 128 + wr * 64 + m * 16 + fr; const size_t o = (size_t)row * 1024 + u.pn * 256 + wc * 32 + 8 * fq;
#pragma unroll
                    for (int bj = 0; bj < 2; ++bj) { f32x4 ga, gb; unpk8(*(const u32x4*)(gs + o + bj * 128), ga, gb);
                        f32x4 a = acc[ai][bj][m][0] * ga, b = acc[ai][bj][m][1] * gb;
                        if (!first) { f32x4 ma, mb; unpk8(*(const u32x4*)(mg + o + bj * 128), ma, mb); a += ma; b += mb; }
                        *(u32x4*)(mg + o + bj * 128) = pk8(a, b); } }
        }
        return; }
    case GK_C3: case GK_D4: case GK_E3: {
        float* X = F.X32;
#pragma unroll
        for (int ai = 0; ai < 2; ++ai)
#pragma unroll
            for (int m = 0; m < 4; ++m) { const int row = row0 + ai * 128 + wr * 64 + m * 16 + fr; float* rp = X + (size_t)row * 1024 + u.pn * 256 + wc * 32 + 8 * fq;
#pragma unroll
                for (int bj = 0; bj < 2; ++bj) { const f32x4 x0 = *(const f32x4*)(rp + bj * 128), x1 = *(const f32x4*)(rp + bj * 128 + 4);
                    *(f32x4*)(rp + bj * 128) = x0 * ALPHA + acc[ai][bj][m][0]; *(f32x4*)(rp + bj * 128 + 4) = x1 * ALPHA + acc[ai][bj][m][1]; } }
        return; }
    case GK_D1: store_plain16(acc, (_Float16*)(ws + WS_QX), 1024, row0, u.pn * 256, 0.0625f * LOG2E, wr, wc, fr, fq); return;
    case GK_D3: store_plain16(acc, (_Float16*)(ws + WS_OX), 1024, row0, u.pn * 256, 1.0f, wr, wc, fr, fq); return;
    case GK_E1: store_plain16(acc, (_Float16*)(ws + WS_UG), 5632, row0, u.pn * 256, 1.0f, wr, wc, fr, fq); return;
    }
}

__device__ __forceinline__ void epilogue_softmax(const Frame& F, const g8::Unit& u, Acc& acc, LAS unsigned char* lds, int wr, int wc, int fr, int fq) {
    LAS float* P = (LAS float*)lds;
    float mx[2][4];
#pragma unroll
    for (int ai = 0; ai < 2; ++ai)
#pragma unroll
        for (int m = 0; m < 4; ++m) { float v = -INFINITY;
#pragma unroll
            for (int bj = 0; bj < 2; ++bj)
#pragma unroll
                for (int n = 0; n < 2; ++n)
#pragma unroll
                    for (int e = 0; e < 4; ++e) v = fmaxf(v, acc[ai][bj][m][n][e]);
            v = fmaxf(v, __shfl_xor(v, 16)); v = fmaxf(v, __shfl_xor(v, 32));
            if (fq == 0) P[(ai * 128 + wr * 64 + m * 16 + fr) * 4 + wc] = v; }
    LDS_WAIT(); __builtin_amdgcn_s_barrier(); asm volatile("" ::: "memory");
#pragma unroll
    for (int ai = 0; ai < 2; ++ai)
#pragma unroll
        for (int m = 0; m < 4; ++m) { const f32x4 t = *(LAS const f32x4*)(P + (ai * 128 + wr * 64 + m * 16 + fr) * 4); mx[ai][m] = fmaxf(fmaxf(t[0], t[1]), fmaxf(t[2], t[3])); }
    LDS_WAIT(); __builtin_amdgcn_s_barrier(); asm volatile("" ::: "memory");
#pragma unroll
    for (int ai = 0; ai < 2; ++ai)
#pragma unroll
        for (int m = 0; m < 4; ++m) { float s = 0.f;
#pragma unroll
            for (int bj = 0; bj < 2; ++bj)
#pragma unroll
                for (int n = 0; n < 2; ++n)
#pragma unroll
                    for (int e = 0; e < 4; ++e) { const float p = __builtin_amdgcn_exp2f(acc[ai][bj][m][n][e] - mx[ai][m]); acc[ai][bj][m][n][e] = p; s += p; }
            s += __shfl_xor(s, 16); s += __shfl_xor(s, 32);
            if (fq == 0) P[(ai * 128 + wr * 64 + m * 16 + fr) * 4 + wc] = s; }
    LDS_WAIT(); __builtin_amdgcn_s_barrier(); asm volatile("" ::: "memory");
    _Float16* dst = (_Float16*)(F.ws + WS_PX);
#pragma unroll
    for (int ai = 0; ai < 2; ++ai)
#pragma unroll
        for (int m = 0; m < 4; ++m) { const int lr = ai * 128 + wr * 64 + m * 16 + fr; const f32x4 t = *(LAS const f32x4*)(P + lr * 4); const float inv = 1.0f / ((t[0] + t[1]) + (t[2] + t[3]));
            _Float16* rp = dst + (size_t)(u.pm * 256 + lr) * 1024 + u.pn * 256 + wc * 32 + 8 * fq;
#pragma unroll
            for (int bj = 0; bj < 2; ++bj) *(u32x4*)(rp + bj * 128) = pk8(acc[ai][bj][m][0] * inv, acc[ai][bj][m][1] * inv); }
    LDS_WAIT(); __builtin_amdgcn_s_barrier(); asm volatile("" ::: "memory");
}

__device__ __forceinline__ void gemm_phase(const Frame& F, int gk, int layer) {
    using namespace g8;
    LAS unsigned char* lds = F.lds;
    const int tid = opaque_tid(), wid = __builtin_amdgcn_readfirstlane(tid >> 6), lane = tid & 63, wr = wid >> 2, wc = wid & 3, fr = lane & 15, fq = lane >> 4;
    int R, C; stage_rc(tid * 16, R, C);
    const unsigned RA = (unsigned)R, RB = (unsigned)((R & ~31) + perm32(R & 31)), C2 = (unsigned)C * 2u;
    const unsigned ldsw = (unsigned)wid * 1024u;
    const int aoff = lds_byte(wr * 64 + fr, fq * 8), boff = lds_byte(wc * 32 + fr, fq * 8);
    const unsigned kstep = (unsigned)(BK * 2);
    const __amdgpu_buffer_rsrc_t rsrc = __builtin_amdgcn_make_buffer_rsrc((void*)F.ws, 0, (int)WS_END, 0x00020000);
#define G8_SA(b, h) (((b) * 2 + (h)) * HTB)
#define G8_SB(b, h) ((4 + (b) * 2 + (h)) * HTB)
#define G8_STAGE(bufoff, gbase, voff, p64) do { \
        __builtin_amdgcn_raw_ptr_buffer_load_lds(rsrc, (LAS void*)(lds + (bufoff) + ldsw), 16, (int)(voff), (int)(gbase), 0, 0); \
        __builtin_amdgcn_raw_ptr_buffer_load_lds(rsrc, (LAS void*)(lds + (bufoff) + ldsw + 8192), 16, (int)(voff), (int)((gbase) + (p64)), 0, 0); } while (0)
#define G8_LDA(dst, b, h) do { _Pragma("unroll") for (int m = 0; m < 4; ++m) _Pragma("unroll") for (int k = 0; k < 2; ++k) dst[m][k] = *(const LAS h8*)(lds + G8_SA(b, h) + aoff + m * 2048 + k * 1024); } while (0)
#define G8_LDB(dst, b, h) do { _Pragma("unroll") for (int n = 0; n < 2; ++n) _Pragma("unroll") for (int k = 0; k < 2; ++k) dst[n][k] = *(const LAS h8*)(lds + G8_SB(b, h) + boff + n * 2048 + k * 1024); } while (0)
#define G8_MMA(ai, bj, At, Bt) do { __builtin_amdgcn_s_setprio(1); _Pragma("unroll") for (int m = 0; m < 4; ++m) _Pragma("unroll") for (int n = 0; n < 2; ++n) _Pragma("unroll") for (int k = 0; k < 2; ++k) \
        acc[ai][bj][m][n] = __builtin_amdgcn_mfma_f32_16x16x32_f16(Bt[n][k], At[m][k], acc[ai][bj][m][n], 0, 0, 0); __builtin_amdgcn_s_setprio(0); } while (0)
#define G8_WAIT_V(n) asm volatile("s_waitcnt vmcnt(" #n ")" ::: "memory")
#define G8_WAIT_L(n) asm volatile("s_waitcnt lgkmcnt(" #n ")" ::: "memory")
#define G8_BAR __builtin_amdgcn_s_barrier()
#define G8_SCHED __builtin_amdgcn_sched_barrier(0)
    Unit cur, nxt; int ui = 0;
    if (!gemm_sched(F, gk, 0, cur)) return;
    Acc acc;
#pragma unroll
    for (int a = 0; a < 2; ++a)
#pragma unroll
        for (int b = 0; b < 2; ++b)
#pragma unroll
            for (int m = 0; m < 4; ++m)
#pragma unroll
                for (int n = 0; n < 2; ++n) acc[a][b][m][n] = (f32x4){0.f, 0.f, 0.f, 0.f};
    h8 At[4][2], B0[2][2], B1[2][2];
    unsigned cA = cur.A, cB = cur.B; int paC = cur.pa, pbC = cur.pb;
    unsigned vAc = RA * (unsigned)paC + C2, vBc = RB * (unsigned)pbC + C2;
    {
        const unsigned hA = 128u * paC, hB = 128u * pbC, qA = 64u * paC, qB = 64u * pbC;
        G8_STAGE(G8_SB(0, 0), cB, vBc, qB); G8_STAGE(G8_SB(0, 1), cB + hB, vBc, qB); G8_STAGE(G8_SA(0, 0), cA, vAc, qA); G8_STAGE(G8_SA(0, 1), cA + hA, vAc, qA);
        if (wr == 1) G8_BAR;
        G8_WAIT_V(2); G8_BAR;
        G8_STAGE(G8_SB(1, 0), cB + kstep, vBc, qB); G8_STAGE(G8_SA(1, 0), cA + kstep, vAc, qA); G8_STAGE(G8_SB(1, 1), cB + hB + kstep, vBc, qB);
        G8_WAIT_V(6); G8_BAR;
    }
    for (;;) {
        const bool has_next = gemm_sched(F, gk, ui + 1, nxt);
        const unsigned nA = has_next ? nxt.A : cA, nB = has_next ? nxt.B : cB;
        const int paN = has_next ? nxt.pa : paC, pbN = has_next ? nxt.pb : pbC;
        const unsigned vAn = RA * (unsigned)paN + C2, vBn = RB * (unsigned)pbN + C2;
        const int nt = cur.nt;
        const unsigned hAc = 128u * paC, qAc = 64u * paC;
        for (int t = 0; t < nt; t += 2) {
            const bool last = (t == nt - 2);
            const unsigned a1 = cA + (unsigned)(t + 1) * kstep;
            const unsigned a2 = last ? nA : cA + (unsigned)(t + 2) * kstep, b2 = last ? nB : cB + (unsigned)(t + 2) * kstep;
            const unsigned a3 = a2 + kstep, b3 = b2 + kstep;
            const int pa2 = last ? paN : paC, pb2 = last ? pbN : pbC;
            const unsigned vA2 = last ? vAn : vAc, vB2 = last ? vBn : vBc;
            const unsigned hA2 = 128u * pa2, hB2 = 128u * pb2, qA2 = 64u * pa2, qB2 = 64u * pb2;
            G8_LDB(B0, 0, 0); G8_LDB(B1, 0, 1); G8_SCHED; G8_LDA(At, 0, 0); G8_STAGE(G8_SA(1, 1), a1 + hAc, vAc, qAc);
            G8_WAIT_V(8); G8_WAIT_L(0); G8_BAR; G8_MMA(0, 0, At, B0); G8_MMA(0, 1, At, B1); G8_BAR; G8_SCHED;
            G8_LDA(At, 0, 1); G8_STAGE(G8_SB(0, 0), b2, vB2, qB2); G8_STAGE(G8_SB(0, 1), b2 + hB2, vB2, qB2); G8_STAGE(G8_SA(0, 0), a2, vA2, qA2);
            G8_WAIT_V(8); G8_WAIT_L(0); G8_BAR; G8_MMA(1, 0, At, B0); G8_MMA(1, 1, At, B1); G8_BAR; G8_SCHED;
            G8_LDB(B0, 1, 0); G8_LDB(B1, 1, 1); G8_SCHED; G8_LDA(At, 1, 0); G8_STAGE(G8_SA(0, 1), a2 + hA2, vA2, qA2);
            G8_WAIT_V(8); G8_WAIT_L(0); G8_BAR; G8_MMA(0, 0, At, B0); G8_MMA(0, 1, At, B1); G8_BAR; G8_SCHED;
            G8_LDA(At, 1, 1); G8_STAGE(G8_SB(1, 0), b3, vB2, qB2); G8_STAGE(G8_SB(1, 1), b3 + hB2, vB2, qB2); G8_STAGE(G8_SA(1, 0), a3, vA2, qA2);
            G8_WAIT_V(8); G8_WAIT_L(0); G8_BAR; G8_MMA(1, 0, At, B0); G8_MMA(1, 1, At, B1); G8_BAR; G8_SCHED;
        }
        if (wr == 0) G8_BAR;
        if (gk != GK_D2) gemm_epilogue(F, gk, layer, cur, acc, wr, wc, fr, fq);
        if (!has_next) break;
#pragma unroll
        for (int a = 0; a < 2; ++a)
#pragma unroll
            for (int b = 0; b < 2; ++b)
#pragma unroll
                for (int m = 0; m < 4; ++m)
#pragma unroll
                    for (int n = 0; n < 2; ++n) acc[a][b][m][n] = (f32x4){0.f, 0.f, 0.f, 0.f};
        cur = nxt; cA = nA; cB = nB; paC = paN; pbC = pbN; vAc = vAn; vBc = vBn; ++ui;
        if (wr == 1) G8_BAR;
    }
    G8_WAIT_V(0);
    G8_BAR;
    if (gk == GK_D2) epilogue_softmax(F, cur, acc, lds, wr, wc, fr, fq);
#undef G8_SA
#undef G8_SB
#undef G8_STAGE
#undef G8_LDA
#undef G8_LDB
#undef G8_MMA
#undef G8_WAIT_V
#undef G8_WAIT_L
#undef G8_BAR
#undef G8_SCHED
}

namespace fa {
constexpr int KSLOT = 8192, VSLOT = 16384, NSLOT = 3;
constexpr int LDS_K = 0, LDS_V = NSLOT * KSLOT, LDS_WS = LDS_V + NSLOT * VSLOT, LDS_RPB = LDS_WS + NWAVES * 64 * 4, LDS_END = LDS_RPB + 2048;
constexpr float THR = 8.0f;
__device__ __forceinline__ int crow(int r, int hi) { return (r & 3) + 8 * (r >> 2) + 4 * hi; }
__device__ __forceinline__ void glds16(const void* gsrc, unsigned lds_dst) { unsigned keep;
    asm volatile("s_mov_b32 %0, m0\n\ts_mov_b32 m0, %2\n\ts_nop 0\n\tglobal_load_lds_dwordx4 %1, off\n\ts_mov_b32 m0, %0" : "=&s"(keep) : "v"(gsrc), "s"(lds_dst) : "memory"); }
__device__ __forceinline__ float swapmax(float m) { auto rr = __builtin_amdgcn_permlane32_swap(__float_as_uint(m), __float_as_uint(m), false, false); return fmaxf(__uint_as_float(rr[0]), __uint_as_float(rr[1])); }
__device__ __forceinline__ float swapsum(float m) { auto rr = __builtin_amdgcn_permlane32_swap(__float_as_uint(m), __float_as_uint(m), false, false); return __uint_as_float(rr[0]) + __uint_as_float(rr[1]); }
typedef short v4i16_t __attribute__((ext_vector_type(4)));
__device__ __forceinline__ s16x4 vtr(LAS const char* p) { return __builtin_bit_cast(s16x4, __builtin_amdgcn_ds_read_tr16_b64_v4i16((LAS v4i16_t*)p)); }
#define FA_WAIT_BAR(N) asm volatile("s_waitcnt vmcnt(" #N ") lgkmcnt(0)\n\ts_barrier" ::: "memory")

__device__ __forceinline__ void qk_tile(f32x16& p0, f32x16& p1, LAS const char* kslot, const h8 (&qr)[4], const f32x16& negm, int r32, int hi) {
    LAS const char* kb = kslot + hi * 1024 + r32 * 16;
#pragma unroll
    for (int d0 = 0; d0 < 4; ++d0) {
        const h8 b0 = *(LAS const h8*)(kb + d0 * 2048), b1 = *(LAS const h8*)(kb + d0 * 2048 + 512);
        if (d0 == 0) { p0 = __builtin_amdgcn_mfma_f32_32x32x16_f16(b0, qr[0], negm, 0, 0, 0); p1 = __builtin_amdgcn_mfma_f32_32x32x16_f16(b1, qr[0], negm, 0, 0, 0); }
        else { p0 = __builtin_amdgcn_mfma_f32_32x32x16_f16(b0, qr[d0], p0, 0, 0, 0); p1 = __builtin_amdgcn_mfma_f32_32x32x16_f16(b1, qr[d0], p1, 0, 0, 0); } }
}
template <int NDQ> __device__ __forceinline__ void pv_tile(f32x16 (&o)[NDQ], LAS const char* vlane, const u32x4 (&pw)[4]) {
#pragma unroll
    for (int dq = 0; dq < NDQ; ++dq) {
        s16x4 lo[4], hi[4];
#pragma unroll
        for (int ks = 0; ks < 4; ++ks) { lo[ks] = vtr(vlane + dq * 4096 + ks * 1024); hi[ks] = vtr(vlane + dq * 4096 + ks * 1024 + 512); }
#pragma unroll
        for (int ks = 0; ks < 4; ++ks) { const s16x8 v = {lo[ks][0], lo[ks][1], lo[ks][2], lo[ks][3], hi[ks][0], hi[ks][1], hi[ks][2], hi[ks][3]};
            o[dq] = __builtin_amdgcn_mfma_f32_32x32x16_f16(__builtin_bit_cast(h8, pw[ks]), __builtin_bit_cast(h8, v), o[dq], 0, 0, 0); }
        __builtin_amdgcn_sched_barrier(0);
    }
}
template <int NDQ> __device__ __forceinline__ void softmax_tile(f32x16& p0, f32x16& p1, u32x4 (&pw)[4], f32x16 (&o)[NDQ], float& mhat, float& l, f32x16& negm, bool first, LAS float* wsf, int r32, int hi) {
    float rm = fmaxf(p0[0], p1[0]);
#pragma unroll
    for (int r = 1; r < 16; ++r) rm = fmaxf(rm, fmaxf(p0[r], p1[r]));
    rm = swapmax(rm);
    if (first || __any(rm > THR)) {
        const float dl = first ? rm : fmaxf(rm, 0.f);
        mhat += dl;
#pragma unroll
        for (int r = 0; r < 16; ++r) { p0[r] -= dl; p1[r] -= dl; negm[r] = -mhat; }
        if (!first) {
            const float f = __builtin_amdgcn_exp2f(-dl); l *= f;
            if (hi == 0) wsf[r32] = f;
            LDS_WAIT();
#pragma unroll
            for (int r = 0; r < 16; ++r) { const float fr_ = wsf[crow(r, hi)];
#pragma unroll
                for (int dq = 0; dq < NDQ; ++dq) o[dq][r] *= fr_; }
            LDS_WAIT();
        }
    }
    float s = 0.f;
#pragma unroll
    for (int r = 0; r < 16; ++r) { p0[r] = __builtin_amdgcn_exp2f(p0[r]); p1[r] = __builtin_amdgcn_exp2f(p1[r]); s += p0[r] + p1[r]; }
    l += s;
    pw[0] = (u32x4){pkh(p0[0], p0[1]), pkh(p0[2], p0[3]), pkh(p0[4], p0[5]), pkh(p0[6], p0[7])};
    pw[1] = (u32x4){pkh(p0[8], p0[9]), pkh(p0[10], p0[11]), pkh(p0[12], p0[13]), pkh(p0[14], p0[15])};
    pw[2] = (u32x4){pkh(p1[0], p1[1]), pkh(p1[2], p1[3]), pkh(p1[4], p1[5]), pkh(p1[6], p1[7])};
    pw[3] = (u32x4){pkh(p1[8], p1[9]), pkh(p1[10], p1[11]), pkh(p1[12], p1[13]), pkh(p1[14], p1[15])};
}

__device__ __forceinline__ void diff_unit(const Frame& F, int layer, int unit) {
    LAS unsigned char* lds = F.lds; unsigned char* ws = F.ws;
    const int tid = opaque_tid(), lane = tid & 63, r32 = lane & 31, hi = lane >> 5, wid = __builtin_amdgcn_readfirstlane(tid >> 6);
    const int bh = unit >> 5, qb = unit & 31, b = bh >> 2, h = bh & 3;
    const long rowbase = (long)b * SEQ; const int q0 = qb * 256;
    _Float16* QA = (_Float16*)(ws + WS_QA); const _Float16* KA = (const _Float16*)(ws + WS_KA); const _Float16* VA = (const _Float16*)(ws + WS_VA);
    const unsigned lds0 = (unsigned)(uintptr_t)lds;
    LAS float* wsf = (LAS float*)(lds + LDS_WS) + wid * 64;
    LAS const char* kbase = (LAS const char*)lds + LDS_K;
    LAS const char* vlane0 = (LAS const char*)lds + LDS_V + ((lane >> 4) & 1) * 32 + (lane & 3) * 8 + (4 * hi + ((lane & 15) >> 2)) * 64;
    constexpr int NT = SEQ / 64;
    const float lam = ((const float*)(ws + WS_MISC))[layer];
    const float lam_init = layer == 0 ? 0.2f : 0.35550906759096926f;
    for (int mp = 0; mp < 2; ++mp) {
        const _Float16* Qw = QA + (rowbase + q0 + wid * 32) * 512 + h * 128 + mp * 64;
        h8 qr[4];
#pragma unroll
        for (int d0 = 0; d0 < 4; ++d0) qr[d0] = *(const h8*)(Qw + (long)r32 * 512 + d0 * 16 + hi * 8);
        const _Float16* ksrc = KA + (rowbase + lane) * 512 + h * 128 + mp * 64 + wid * 8;
        const _Float16* vsrc = VA + (rowbase + 16 * (wid & 3) + (lane >> 2)) * 512 + h * 128 + (wid >> 2) * 32 + (lane & 3) * 8;
        const unsigned kdst = lds0 + LDS_K + wid * 1024, vdst = lds0 + LDS_V + wid * 1024;
#define FA_DMA(t, slot) do { glds16(ksrc + (long)(t) * 64 * 512, (unsigned)__builtin_amdgcn_readfirstlane(kdst + (slot) * KSLOT)); \
        glds16(vsrc + (long)(t) * 64 * 512, (unsigned)__builtin_amdgcn_readfirstlane(vdst + (slot) * VSLOT)); \
        glds16(vsrc + (long)(t) * 64 * 512 + 64, (unsigned)__builtin_amdgcn_readfirstlane(vdst + (slot) * VSLOT + 8192)); } while (0)
        float mhat = 0.f, l = 0.f; f32x16 o[4]; f32x16 negm;
#pragma unroll
        for (int r = 0; r < 16; ++r) { negm[r] = 0.f; o[0][r] = 0.f; o[1][r] = 0.f; o[2][r] = 0.f; o[3][r] = 0.f; }
        FA_DMA(0, 0); FA_DMA(1, 1);
        int slot = 0, slot2 = 2;
        for (int t = 0; t < NT; ++t) {
            FA_WAIT_BAR(3);
            { const int t2 = t + 2 < NT ? t + 2 : NT - 1; FA_DMA(t2, slot2); }
            f32x16 p0, p1; u32x4 pw[4];
            qk_tile(p0, p1, kbase + slot * KSLOT, qr, negm, r32, hi);
            softmax_tile<4>(p0, p1, pw, o, mhat, l, negm, t == 0, wsf, r32, hi);
            pv_tile<4>(o, vlane0 + slot * VSLOT, pw);
            slot = slot == 2 ? 0 : slot + 1; slot2 = slot2 == 2 ? 0 : slot2 + 1;
        }
        FA_WAIT_BAR(0);
#undef FA_DMA
        int tidE = tid; asm volatile("" : "+v"(tidE));
        const int r32E = tidE & 31, hiE = (tidE >> 5) & 1;
        LAS float* wsfE = (LAS float*)(lds + LDS_WS) + wid * 64;
        l = swapsum(l);
        if (hiE == 0) wsfE[32 + r32E] = l;
        LDS_WAIT();
        float rli[16];
#pragma unroll
        for (int r = 0; r < 16; ++r) rli[r] = 1.0f / wsfE[32 + crow(r, hiE)];
        LDS_WAIT();
        float* stash = (float*)(ws + WS_STASH) + (size_t)unit * (512 * 64) + (size_t)tidE * 4;
        if (mp == 0) {
#pragma unroll
            for (int dq = 0; dq < 4; ++dq)
#pragma unroll
                for (int j = 0; j < 4; ++j) { f32x4 v; v[0] = o[dq][4 * j] * rli[4 * j]; v[1] = o[dq][4 * j + 1] * rli[4 * j + 1]; v[2] = o[dq][4 * j + 2] * rli[4 * j + 2]; v[3] = o[dq][4 * j + 3] * rli[4 * j + 3];
                    *(f32x4*)(stash + (size_t)(dq * 4 + j) * 2048) = v; }
        } else {
            float ss[16];
#pragma unroll
            for (int r = 0; r < 16; ++r) ss[r] = 0.f;
#pragma unroll
            for (int dq = 0; dq < 4; ++dq) {
#pragma unroll
                for (int j = 0; j < 4; ++j) { const f32x4 s1 = *(const f32x4*)(stash + (size_t)(dq * 4 + j) * 2048);
#pragma unroll
                    for (int e = 0; e < 4; ++e) { const int r = 4 * j + e; const float d = s1[e] - lam * (o[dq][r] * rli[r]); o[dq][r] = d; ss[r] += d * d; } }
                __builtin_amdgcn_sched_barrier(0); }
#pragma unroll
            for (int r = 0; r < 16; ++r) { float v = ss[r]; v += __shfl_xor(v, 1); v += __shfl_xor(v, 2); v += __shfl_xor(v, 4); v += __shfl_xor(v, 8); v += __shfl_xor(v, 16);
                ss[r] = (1.0f - lam_init) / sqrtf(v * (1.0f / 128.0f) + LN_EPS); }
            const float* sg = inptr<I_SUBG>() + layer * 128;
            _Float16* Yw = QA + (rowbase + q0 + wid * 32) * 512 + h * 128 + r32E;
#pragma unroll
            for (int dq = 0; dq < 4; ++dq) { const float g = sg[dq * 32 + r32E];
#pragma unroll
                for (int r = 0; r < 16; ++r) Yw[(long)crow(r, hiE) * 512 + dq * 32] = (_Float16)(o[dq][r] * ss[r] * g); }
        }
    }
}

__device__ __forceinline__ void na_unit(const Frame& F, int layer, int unit) {
    LAS unsigned char* lds = F.lds; unsigned char* ws = F.ws;
    const int tid = opaque_tid(), lane = tid & 63, r32 = lane & 31, hi = lane >> 5, wid = __builtin_amdgcn_readfirstlane(tid >> 6);
    const int bh = unit >> 5, rb = unit & 31, b = bh >> 3, h = bh & 7;
    const long rowbase = (long)b * SEQ; const int r0 = rb * 4;
    _Float16* QB = (_Float16*)(ws + WS_QB); const _Float16* KB = (const _Float16*)(ws + WS_KB); const _Float16* VB = (const _Float16*)(ws + WS_VB);
    const unsigned lds0 = (unsigned)(uintptr_t)lds;
    LAS float* wsf = (LAS float*)(lds + LDS_WS) + wid * 64;
    LAS float* rpbL = (LAS float*)(lds + LDS_RPB);
    LAS const char* kbase = (LAS const char*)lds + LDS_K;
    LAS const char* vlane0 = (LAS const char*)lds + LDS_V + ((lane >> 4) & 1) * 32 + (lane & 3) * 8 + (4 * hi + ((lane & 15) >> 2)) * 64;
    { const float* rp = inptr<I_RPB>() + ((size_t)layer * 8 + h) * (15 * 31);
      if (tid < 480) { const int dr = tid >> 5, dc = tid & 31; rpbL[tid] = dc < 31 ? rp[dr * 31 + dc] * LOG2E : 0.f; } }
    const int rq = r0 + (wid >> 1), J = wid & 1;
    const int c = 32 * J + r32;
    int cs = c - 8; cs = cs < 0 ? 0 : (cs > 48 ? 48 : cs);
    int rs_w = rq - 4; rs_w = rs_w < 0 ? 0 : (rs_w > 120 ? 120 : rs_w);
    int kr0 = r0 - 4; kr0 = kr0 < 0 ? 0 : (kr0 > 120 ? 120 : kr0);
    int kr1 = r0 + 3 - 4; kr1 = kr1 < 0 ? 0 : (kr1 > 120 ? 120 : kr1); kr1 += 8;
    const int NT = kr1 - kr0;
    const _Float16* Qw = QB + (rowbase + rq * 64 + J * 32) * 512 + h * 64;
    h8 qr[4];
#pragma unroll
    for (int d0 = 0; d0 < 4; ++d0) qr[d0] = *(const h8*)(Qw + (long)r32 * 512 + d0 * 16 + hi * 8);
    const _Float16* ksrc = KB + (rowbase + lane) * 512 + h * 64 + wid * 8;
    const _Float16* vsrc = VB + (rowbase + 16 * (wid & 3) + (lane >> 2)) * 512 + h * 64 + (wid >> 2) * 32 + (lane & 3) * 8;
    const unsigned kdst = lds0 + LDS_K + wid * 1024, vdst = lds0 + LDS_V + wid * 1024;
#define NA_DMA(t, slot) do { glds16(ksrc + (long)(t) * 64 * 512, (unsigned)__builtin_amdgcn_readfirstlane(kdst + (slot) * KSLOT)); \
        glds16(vsrc + (long)(t) * 64 * 512, (unsigned)__builtin_amdgcn_readfirstlane(vdst + (slot) * VSLOT)); } while (0)
    float mhat = 0.f, l = 0.f; f32x16 o[2]; f32x16 negm;
#pragma unroll
    for (int r = 0; r < 16; ++r) { negm[r] = 0.f; o[0][r] = 0.f; o[1][r] = 0.f; }
    NA_DMA(kr0, 0); NA_DMA(kr0 + 1, 1);
    int slot = 0, slot2 = 2;
    for (int t = 0; t < NT; ++t) {
        FA_WAIT_BAR(2);
        { const int t2 = t + 2 < NT ? t + 2 : NT - 1; NA_DMA(kr0 + t2, slot2); }
        const int kr = kr0 + t;
        if (kr >= rs_w && kr < rs_w + 8) {
            f32x16 p0, p1; u32x4 pw[4];
            qk_tile(p0, p1, kbase + slot * KSLOT, qr, negm, r32, hi);
            const int dr = kr - rq + 7;
#pragma unroll
            for (int r = 0; r < 16; ++r) {
                const int k0 = crow(r, hi), k1 = k0 + 32;
                const bool v0 = (k0 >= cs) && (k0 < cs + 16), v1 = (k1 >= cs) && (k1 < cs + 16);
                int d0 = k0 - c + 15, d1 = k1 - c + 15; d0 = d0 < 0 ? 0 : (d0 > 30 ? 30 : d0); d1 = d1 < 0 ? 0 : (d1 > 30 ? 30 : d1);
                p0[r] = v0 ? p0[r] + rpbL[dr * 32 + d0] : -INFINITY; p1[r] = v1 ? p1[r] + rpbL[dr * 32 + d1] : -INFINITY; }
            softmax_tile<2>(p0, p1, pw, o, mhat, l, negm, kr == rs_w, wsf, r32, hi);
            pv_tile<2>(o, vlane0 + slot * VSLOT, pw);
        }
        slot = slot == 2 ? 0 : slot + 1; slot2 = slot2 == 2 ? 0 : slot2 + 1;
    }
    FA_WAIT_BAR(0);
#undef NA_DMA
    l = swapsum(l);
    if (hi == 0) wsf[32 + r32] = l;
    LDS_WAIT();
    float rli[16];
#pragma unroll
    for (int r = 0; r < 16; ++r) rli[r] = 1.0f / wsf[32 + crow(r, hi)];
    LDS_WAIT();
    _Float16* Yw = QB + (rowbase + rq * 64 + J * 32) * 512 + h * 64;
#pragma unroll
    for (int dq = 0; dq < 2; ++dq)
#pragma unroll
        for (int r = 0; r < 16; ++r) Yw[(long)crow(r, hi) * 512 + dq * 32 + r32] = (_Float16)(o[dq][r] * rli[r]);
    asm volatile("s_waitcnt lgkmcnt(0)\n\ts_barrier" ::: "memory");
}
#undef FA_WAIT_BAR
}

__device__ __forceinline__ void sincos_d(float ang, float& c, float& s) {
    const double a = (double)ang; const double k = __builtin_rint(a * 0.63661977236758134308);
    const double r = (a - k * 1.57079632679489655800) - k * 6.12323399573676603587e-17;
    const double r2 = r * r;
    double sp = r2 * (1.0 / 6227020800.0); sp = r2 * (-1.0 / 39916800.0 + sp); sp = r2 * (1.0 / 362880.0 + sp); sp = r2 * (-1.0 / 5040.0 + sp); sp = r2 * (1.0 / 120.0 + sp); sp = r2 * (-1.0 / 6.0 + sp); const double sn = r + r * sp;
    double cp = r2 * (-1.0 / 87178291200.0); cp = r2 * (1.0 / 479001600.0 + cp); cp = r2 * (-1.0 / 3628800.0 + cp); cp = r2 * (1.0 / 40320.0 + cp); cp = r2 * (-1.0 / 720.0 + cp); cp = r2 * (1.0 / 24.0 + cp); cp = r2 * (-0.5 + cp); const double cn = 1.0 + cp;
    const int q = ((int)(long long)k) & 3;
    const double cc = (q == 0) ? cn : (q == 1) ? -sn : (q == 2) ? -cn : sn;
    const double ssn = (q == 0) ? sn : (q == 1) ? cn : (q == 2) ? -sn : -cn;
    c = (float)cc; s = (float)ssn;
}
__device__ const float kInvFreq[32] = {
    1.0f, 0.74989420933245582730f, 0.56234132519034907283f, 0.42169650342858224457f, 0.31622776601683794118f, 0.23713737056616551864f, 0.17782794100389229253f, 0.13335214321633239742f,
    0.1f, 0.074989420933245578289f, 0.056234132519034911446f, 0.042169650342858223069f, 0.031622776601683791342f, 0.023713737056616554640f, 0.017782794100389226478f, 0.013335214321633238354f,
    0.01f, 0.0074989420933245581759f, 0.0056234132519034909712f, 0.0042169650342858226539f, 0.0031622776601683793077f, 0.0023713737056616552472f, 0.0017782794100389228646f, 0.0013335214321633240089f,
    0.001f, 0.00074989420933245577422f, 0.00056234132519034905375f, 0.00042169650342858224370f, 0.00031622776601683794161f, 0.00023713737056616551388f, 0.00017782794100389227562f, 0.00013335214321633239005f };

__device__ __forceinline__ int wmap(int kind, int col0, int n) {
    if (kind == 0) return col0 + n;
    if (n < 1024) { const int j = n & 63; return (n & ~63) + (j >> 1) + 32 * (j & 1); }
    if (n < 3584) return n;
    const int t = (n - 3584) >> 8, w = (n - 3584) & 255;
    return (w < 128 ? 3584 : 4096 - 128) + t * 128 + w;
}
__device__ __forceinline__ void wconv_item(const float* W, int ldw, int K, int N, int kind, int col0, _Float16* WT, LAS float* scr, int item, int lane) {
    const int nblk = N / 32, kb = item / nblk, nb = item % nblk, k0 = 64 * kb, n0 = 32 * nb;
    const int col = wmap(kind, col0, n0 + (lane & 31));
#pragma unroll 8
    for (int i = 0; i < 32; ++i) { const int kk = 2 * i + (lane >> 5); scr[kk * 33 + (lane & 31)] = W[(size_t)(k0 + kk) * ldw + col]; }
    LDS_WAIT(); asm volatile("" ::: "memory");
    const int cch = lane & 7;
#pragma unroll
    for (int j = 0; j < 4; ++j) { const int n = (lane >> 3) + 8 * j; const LAS float* s = scr + (8 * cch) * 33 + n;
        u32x4 o; o.x = pkh(s[0 * 33], s[1 * 33]); o.y = pkh(s[2 * 33], s[3 * 33]); o.z = pkh(s[4 * 33], s[5 * 33]); o.w = pkh(s[6 * 33], s[7 * 33]);
        *(u32x4*)(WT + (size_t)(n0 + n) * K + k0 + 8 * cch) = o; }
    LDS_WAIT(); asm volatile("" ::: "memory");
}
__device__ __forceinline__ void phase_weights(const Frame& F, int layer) {
    LAS float* scr = (LAS float*)(F.lds + F.wave * 16384); const int lane = opaque_tid() & 63;
    const int gw = F.vcu * NWAVES + F.wave, NGW = F.G * NWAVES; unsigned char* ws = F.ws;
    for (int job = 0; job < 12; ++job) {
        const float* src; int ldw, K, N, kind = 0, col0 = 0; size_t dst;
        switch (job) {
        case 0: src = inptr<I_WIN>() + (size_t)layer * 1024 * INCOLS; ldw = INCOLS; K = 1024; N = 4608; kind = 1; dst = WS_WINA; break;
        case 1: src = inptr<I_WIN>() + (size_t)layer * 1024 * INCOLS; ldw = INCOLS; K = 1024; N = 3072; col0 = 4608; dst = WS_WG; break;
        case 2: case 3: case 4: src = inptr<I_WBR>() + ((size_t)layer * 3 + (job - 2)) * 512 * 1024; ldw = 1024; K = 512; N = 1024; dst = WS_WBR + (size_t)(job - 2) * (1024 * 512 * 2); break;
        case 5: src = inptr<I_WMIX>() + (size_t)layer * 1024 * 1024; ldw = 1024; K = 1024; N = 1024; dst = WS_WMIX; break;
        case 6: src = inptr<I_XAQ>() + (size_t)layer * 1024 * 1024; ldw = 1024; K = 1024; N = 1024; dst = WS_WXQ; break;
        case 7: src = inptr<I_XAKV>() + (size_t)layer * 1024 * 2048; ldw = 2048; K = 1024; N = 1024; dst = WS_WXK; break;
        case 8: src = inptr<I_XAKV>() + (size_t)layer * 1024 * 2048; ldw = 2048; K = 1024; N = 1024; col0 = 1024; dst = WS_WXV; break;
        case 9: src = inptr<I_XAO>() + (size_t)layer * 1024 * 1024; ldw = 1024; K = 1024; N = 1024; dst = WS_WXO; break;
        case 10: src = inptr<I_FW1>() + (size_t)layer * 1024 * 5632; ldw = 5632; K = 1024; N = 5632; dst = WS_WF1; break;
        default: src = inptr<I_FW2>() + (size_t)layer * 2816 * 1024; ldw = 1024; K = 2816; N = 1024; dst = WS_WF2; break;
        }
        const int nitems = (K / 64) * (N / 32);
        for (int it = gw; it < nitems; it += NGW) wconv_item(src, ldw, K, N, kind, col0, (_Float16*)(ws + dst), scr, it, lane);
    }
}
__device__ __forceinline__ void ln_row(const float* src, const float* g, const float* bta, float* o32, _Float16* o16, int lane) {
    f32x4 v[4]; float s = 0.f;
#pragma unroll
    for (int j = 0; j < 4; ++j) { v[j] = *(const f32x4*)(src + 256 * j + 4 * lane); s += (v[j][0] + v[j][1]) + (v[j][2] + v[j][3]); }
    const float mean = wave_sum(s) * (1.f / 1024.f); float s2 = 0.f;
#pragma unroll
    for (int j = 0; j < 4; ++j) { v[j] = v[j] - mean; s2 += (v[j][0] * v[j][0] + v[j][1] * v[j][1]) + (v[j][2] * v[j][2] + v[j][3] * v[j][3]); }
    const float rstd = 1.f / sqrtf(wave_sum(s2) * (1.f / 1024.f) + LN_EPS);
#pragma unroll
    for (int j = 0; j < 4; ++j) { const f32x4 gg = *(const f32x4*)(g + 256 * j + 4 * lane), bb = *(const f32x4*)(bta + 256 * j + 4 * lane);
        const f32x4 y = v[j] * rstd * gg + bb; *(f32x4*)(o32 + 256 * j + 4 * lane) = y;
        u32x2 w; w.x = pkh(y[0], y[1]); w.y = pkh(y[2], y[3]); *(u32x2*)(o16 + 256 * j + 4 * lane) = w; }
}
__device__ __forceinline__ void phase_init(const Frame& F) {
    const int gw = F.vcu * NWAVES + F.wave, NGW = F.G * NWAVES; unsigned char* ws = F.ws; const int lane = opaque_tid() & 63;
    _Float16* XH = (_Float16*)(ws + WS_XH);
    { const float* xin = inptr<I_X>(); const float* eg = inptr<I_EMBG>(); const float* eb = inptr<I_EMBB>();
      for (int m = gw; m < MTOK; m += NGW) ln_row(xin + (size_t)m * 1024, eg, eb, F.X32 + (size_t)m * 1024, XH + (size_t)m * 1024, lane); }
    { f32x2* cs = (f32x2*)(ws + WS_CS);
      for (int e = gw * 64 + lane; e < SEQ * 32; e += NGW * 64) { const int pos = e >> 5, i = e & 31; const float ang = (float)pos * kInvFreq[i]; float c, s; sincos_d(ang, c, s); cs[e] = (f32x2){c, s}; } }
    { const float* mem = inptr<I_MEM>(); _Float16* mh = (_Float16*)(ws + WS_MEMH);
      for (int e = gw * 64 + lane; e < 512 * 1024 / 4; e += NGW * 64) { const f32x4 v = *(const f32x4*)(mem + (size_t)e * 4); u32x2 w; w.x = pkh(v[0], v[1]); w.y = pkh(v[2], v[3]); *(u32x2*)(mh + (size_t)e * 4) = w; } }
    if (gw == 0) { float* lamo = (float*)(ws + WS_MISC);
      const float* q1 = inptr<I_LQ1>(); const float* k1 = inptr<I_LK1>(); const float* q2 = inptr<I_LQ2>(); const float* k2 = inptr<I_LK2>();
      for (int l = 0; l < NLAYER; ++l) { const float a = wave_sum(q1[l * 64 + lane] * k1[l * 64 + lane]), b2 = wave_sum(q2[l * 64 + lane] * k2[l * 64 + lane]);
          const float lam_init = l == 0 ? 0.2f : 0.35550906759096926f; if (lane == 0) lamo[l] = expf(a) - expf(b2) + lam_init; } }
}
__device__ __forceinline__ void phase_ln(const Frame& F, int layer, int which) {
    const int gw = F.vcu * NWAVES + F.wave, NGW = F.G * NWAVES, lane = opaque_tid() & 63; _Float16* XH = (_Float16*)(F.ws + WS_XH);
    const float* g = inptr<I_LNG>() + ((size_t)layer * 3 + which) * 1024; const float* b = inptr<I_LNB>() + ((size_t)layer * 3 + which) * 1024;
    for (int m = gw; m < MTOK; m += NGW) ln_row(F.X32 + (size_t)m * 1024, g, b, F.X32 + (size_t)m * 1024, XH + (size_t)m * 1024, lane);
}
__device__ __forceinline__ void phase_shortconv(const Frame& F, int layer) {
    const int gw = F.vcu * NWAVES + F.wave, NGW = F.G * NWAVES, lane = opaque_tid() & 63; unsigned char* ws = F.ws;
    _Float16* GB = (_Float16*)(ws + WS_GB); const _Float16* P = (const _Float16*)(ws + WS_GCHC);
    const float* w = inptr<I_SCW>() + (size_t)layer * 3 * 512;
    f32x4 w0a = *(const f32x4*)(w + 8 * lane), w0b = *(const f32x4*)(w + 8 * lane + 4), w1a = *(const f32x4*)(w + 512 + 8 * lane), w1b = *(const f32x4*)(w + 512 + 8 * lane + 4), w2a = *(const f32x4*)(w + 1024 + 8 * lane), w2b = *(const f32x4*)(w + 1024 + 8 * lane + 4);
    for (int m = gw; m < MTOK; m += NGW) { const int pos = m & (SEQ - 1);
        f32x4 ca, cb, pa = {0.f, 0.f, 0.f, 0.f}, pb = pa, na = pa, nb = pa, ga, gb;
        unpk8(*(const u32x4*)(P + (size_t)m * 512 + 8 * lane), ca, cb);
        if (pos > 0) unpk8(*(const u32x4*)(P + (size_t)(m - 1) * 512 + 8 * lane), pa, pb);
        if (pos < SEQ - 1) unpk8(*(const u32x4*)(P + (size_t)(m + 1) * 512 + 8 * lane), na, nb);
        unpk8(*(const u32x4*)(GB + (size_t)m * 512 + 8 * lane), ga, gb);
        const f32x4 ya = ga * (w0a * pa + w1a * ca + w2a * na), yb = gb * (w0b * pb + w1b * cb + w2b * nb);
        *(u32x4*)(GB + (size_t)m * 512 + 8 * lane) = pk8(ya, yb); }
}
__device__ __forceinline__ void phase_ffnact(const Frame& F, int layer) {
    const int gw = F.vcu * NWAVES + F.wave, NGW = F.G * NWAVES, lane = opaque_tid() & 63; unsigned char* ws = F.ws;
    _Float16* UG = (_Float16*)(ws + WS_UG);
    const float* w = inptr<I_FCW>() + (size_t)layer * 3 * DFF; const float* bias = inptr<I_FCB>() + (size_t)layer * DFF;
    for (int m = gw; m < MTOK; m += NGW) { const int pos = m & (SEQ - 1); _Float16* row = UG + (size_t)m * 5632;
        for (int ch = 8 * lane; ch < DFF; ch += 512) {
            f32x4 ca, cb, pa = {0.f, 0.f, 0.f, 0.f}, pb = pa, na = pa, nb = pa, ua, ub;
            unpk8(*(const u32x4*)(row + DFF + ch), ca, cb);
            if (pos > 0) unpk8(*(const u32x4*)(row - 5632 + DFF + ch), pa, pb);
            if (pos < SEQ - 1) unpk8(*(const u32x4*)(row + 5632 + DFF + ch), na, nb);
            unpk8(*(const u32x4*)(row + ch), ua, ub);
            const f32x4 w0a = *(const f32x4*)(w + ch), w0b = *(const f32x4*)(w + ch + 4), w1a = *(const f32x4*)(w + DFF + ch), w1b = *(const f32x4*)(w + DFF + ch + 4), w2a = *(const f32x4*)(w + 2 * DFF + ch), w2b = *(const f32x4*)(w + 2 * DFF + ch + 4);
            const f32x4 ba = *(const f32x4*)(bias + ch), bb = *(const f32x4*)(bias + ch + 4);
            f32x4 aa = w0a * pa + w1a * ca + w2a * na + ba, ab = w0b * pb + w1b * cb + w2b * nb + bb;
#pragma unroll
            for (int e = 0; e < 4; ++e) { aa[e] = aa[e] * sigmoidf_(aa[e]) * ua[e]; ab[e] = ab[e] * sigmoidf_(ab[e]) * ub[e]; }
            *(u32x4*)(row + ch) = pk8(aa, ab); } }
}

#define XB_TMO      128
#define XB_XCNT(j)  (256  + 64 * (j))
#define XB_XSUB(j)  (1280 + 64 * (j))
#define XB_XGEN(j)  (2304 + 64 * (j))
#define XB_TOP      3328
#define XB_TOPGEN   3392
#define XCD_BAR_WORDS 3456
#define XB_SPIN_CAP (1u << 22)
__device__ __forceinline__ unsigned xb_ld(unsigned* p)              { return __hip_atomic_load(p, __ATOMIC_RELAXED, __HIP_MEMORY_SCOPE_AGENT); }
__device__ __forceinline__ unsigned xb_add(unsigned* p, unsigned v) { return __hip_atomic_fetch_add(p, v, __ATOMIC_RELAXED, __HIP_MEMORY_SCOPE_AGENT); }
__device__ __forceinline__ unsigned xb_xcc_id() { return (unsigned)__builtin_amdgcn_s_getreg((3 << 11) | 20) & 0xFu; }
#define XB_SPIN(cond, bar) do { unsigned _sp = 0; while (cond) { __builtin_amdgcn_s_sleep(1); \
    if ((++_sp & 255u) == 0u) { if (xb_ld(&(bar)[XB_TMO])) break; if (_sp > XB_SPIN_CAP) { atomicAdd(&(bar)[XB_TMO], 1u); break; } } } } while (0)
struct XcdBarrier { unsigned* bar; unsigned x; volatile LAS unsigned* st; };
__device__ __forceinline__ XcdBarrier xcd_barrier_post(unsigned* bar, volatile LAS unsigned* st) {
    XcdBarrier b; b.bar = bar; b.x = xb_xcc_id(); b.st = st;
    if (threadIdx.x == 0) (void)xb_add(&bar[XB_XCNT(b.x)], 1u);
    return b;
}
__device__ __forceinline__ void xcd_barrier_complete(unsigned* bar, unsigned x, unsigned& nloc, unsigned& nx) {
    const unsigned G = gridDim.x * gridDim.y * gridDim.z;
    unsigned sum, cnt, mine, sp = 0u;
    for (;;) {
        sum = 0u; cnt = 0u; mine = 0u;
#pragma unroll
        for (unsigned j = 0; j < 16; ++j) { const unsigned c = xb_ld(&bar[XB_XCNT(j)]); sum += c; cnt += (c > 0u) ? 1u : 0u; mine = (j == x) ? c : mine; }
        if (sum == G) break;
        __builtin_amdgcn_s_sleep(1);
        if ((++sp & 255u) == 0u) { if (xb_ld(&bar[XB_TMO])) break; if (sp > XB_SPIN_CAP) { atomicAdd(&bar[XB_TMO], 1u); break; } }
    }
    nloc = mine > 0u ? mine : 1u; nx = cnt > 0u ? cnt : 1u;
}
__device__ __forceinline__ void xcd_barrier(const XcdBarrier& b) {
    asm volatile("s_waitcnt vmcnt(0)" ::: "memory");
    __syncthreads();
    if (threadIdx.x == 0) {
        unsigned* bar = b.bar;
        __builtin_amdgcn_s_waitcnt(0);
        unsigned nloc = b.st[0], nx = b.st[1];
        if (nloc == 0u) { xcd_barrier_complete(bar, b.x, nloc, nx); b.st[0] = nloc; b.st[1] = nx; }
        const unsigned old = xb_add(&bar[XB_XSUB(b.x)], 1u);
        const unsigned gen = old / nloc;
        if (old + 1u == (gen + 1u) * nloc) {
            __builtin_amdgcn_fence(__ATOMIC_RELEASE, "agent");
            asm volatile("s_waitcnt vmcnt(0)" ::: "memory");
            const unsigned og = xb_add(&bar[XB_TOP], 1u);
            const unsigned tg = og / nx;
            if (og + 1u == (tg + 1u) * nx) xb_add(&bar[XB_TOPGEN], 1u);
            else XB_SPIN(xb_ld(&bar[XB_TOPGEN]) == tg, bar);
            __builtin_amdgcn_fence(__ATOMIC_ACQUIRE, "agent");
            xb_add(&bar[XB_XGEN(b.x)], 1u);
            asm volatile("s_waitcnt vmcnt(0)" ::: "memory");
        } else {
            XB_SPIN(xb_ld(&bar[XB_XGEN(b.x)]) == gen, bar);
            __builtin_amdgcn_fence(__ATOMIC_ACQUIRE, "agent");
            asm volatile("s_waitcnt vmcnt(0)" ::: "memory");
        }
    }
    __syncthreads();
}


#ifndef MK_CHECK
#define MK_CHECK 0
#endif
#if MK_CHECK
constexpr size_t WS_DBG = 246 * MiB;
constexpr int CW_ERR = 1024;
enum { CK_XH0 = 0, CK_W, CK_A, CK_YA, CK_YB, CK_YC, CK_MG, CK_LN1, CK_D1, CK_D2, CK_D3, CK_LN2, CK_E1, CK_E2, CK_LN3, CK_N };
__device__ __forceinline__ unsigned hsh(unsigned x) { x ^= x >> 16; x *= 0x7feb352du; x ^= x >> 15; x *= 0x846ca68bu; x ^= x >> 16; return x; }
__device__ const int kFixedRows[12] = {0, 1, 63, 64, 65, 8191, 8192, 8193, 16383, 255, 256, 4095};
__device__ __forceinline__ int sample_row(int sidx) { return sidx < 12 ? kFixedRows[sidx] : (int)(hsh(sidx * 2654435761u + 17u) % MTOK); }
__device__ float blk_sum(float v, float* red) {
    __syncthreads(); red[threadIdx.x] = v; __syncthreads();
    for (int o = 128; o > 0; o >>= 1) { if ((int)threadIdx.x < o) red[threadIdx.x] += red[threadIdx.x + o]; __syncthreads(); }
    const float r = red[0]; __syncthreads(); return r; }
__device__ float blk_max(float v, float* red) {
    __syncthreads(); red[threadIdx.x] = v; __syncthreads();
    for (int o = 128; o > 0; o >>= 1) { if ((int)threadIdx.x < o) red[threadIdx.x] = fmaxf(red[threadIdx.x], red[threadIdx.x + o]); __syncthreads(); }
    const float r = red[0]; __syncthreads(); return r; }
__device__ void report(unsigned char* ws, int ck, float fast, float ref, float flo) {
    float e = fabsf(fast - ref) / (flo + fabsf(ref)); if (!(e == e)) e = 1e30f;
    atomicMax((unsigned*)(ws + WS_CTL) + CW_ERR + ck, __float_as_uint(e)); }
__device__ float blk_dot_h(const _Float16* a, const float* w, size_t wstride, int n, float* red) {
    float acc = 0.f; for (int k = threadIdx.x; k < n; k += 256) acc += (float)a[k] * (float)(_Float16)w[(size_t)k * wstride]; return blk_sum(acc, red); }
__device__ void ln_ref(float* v  , const float* g, const float* b, float* red) {
    float s = 0.f; for (int c = threadIdx.x; c < 1024; c += 256) s += v[c]; const float mean = blk_sum(s, red) / 1024.f;
    float q = 0.f; for (int c = threadIdx.x; c < 1024; c += 256) { const float d = v[c] - mean; q += d * d; } const float rstd = 1.0f / sqrtf(blk_sum(q, red) / 1024.f + LN_EPS);
    for (int c = threadIdx.x; c < 1024; c += 256) v[c] = (v[c] - mean) * rstd * g[c] + b[c]; __syncthreads(); }

__global__ void __launch_bounds__(256) snap_kernel(Params p) {
    const int m = sample_row(blockIdx.x); float* dst = (float*)(p.ws + WS_DBG) + blockIdx.x * 1024;
    for (int c = threadIdx.x; c < 1024; c += 256) dst[c] = p.out[(size_t)m * 1024 + c];
}
__global__ void __launch_bounds__(256) chk_kernel(Params p, int ck, int layer) {
    extern __shared__ __attribute__((aligned(16))) float dsh[]; float* sh = dsh; float* red = dsh + 16384 + 2048;
    const int slot = ck + layer * CK_N;
    unsigned char* ws = p.ws; const int tid = threadIdx.x, sidx = blockIdx.x; const int m = sample_row(sidx), b = m >> 13, pos = m & 8191;
    const _Float16* XH = (const _Float16*)(ws + WS_XH);
    const float* w_in = p.in[I_WIN] + (size_t)layer * 1024 * INCOLS;
    switch (ck) {
    case CK_XH0: { for (int c = tid; c < 1024; c += 256) sh[c] = p.in[I_X][(size_t)m * 1024 + c]; __syncthreads(); ln_ref(sh, p.in[I_EMBG], p.in[I_EMBB], red);
        for (int c = tid; c < 1024; c += 256) { report(ws, slot, (float)XH[(size_t)m * 1024 + c], sh[c], 0.05f); report(ws, slot, p.out[(size_t)m * 1024 + c], sh[c], 0.05f); } break; }
    case CK_W: { const unsigned r = hsh(sidx * 256 + tid + 12345u);
        { const int n = r % 4608, k = (r >> 13) % 1024; report(ws, slot, (float)((const _Float16*)(ws + WS_WINA))[(size_t)n * 1024 + k], (float)(_Float16)w_in[(size_t)k * INCOLS + wmap(1, 0, n)], 1e-6f); }
        { const int n = r % 3072, k = (r >> 13) % 1024; report(ws, slot, (float)((const _Float16*)(ws + WS_WG))[(size_t)n * 1024 + k], (float)(_Float16)w_in[(size_t)k * INCOLS + 4608 + n], 1e-6f); }
        { const int i = r % 3, n = (r >> 3) % 1024, k = (r >> 14) % 512; report(ws, slot, (float)((const _Float16*)(ws + WS_WBR))[((size_t)i * 1024 + n) * 512 + k], (float)(_Float16)p.in[I_WBR][(((size_t)layer * 3 + i) * 512 + k) * 1024 + n], 1e-6f); }
        { const int n = r % 1024, k = (r >> 11) % 1024;
          report(ws, slot, (float)((const _Float16*)(ws + WS_WMIX))[(size_t)n * 1024 + k], (float)(_Float16)p.in[I_WMIX][((size_t)layer * 1024 + k) * 1024 + n], 1e-6f);
          report(ws, slot, (float)((const _Float16*)(ws + WS_WXQ))[(size_t)n * 1024 + k], (float)(_Float16)p.in[I_XAQ][((size_t)layer * 1024 + k) * 1024 + n], 1e-6f);
          report(ws, slot, (float)((const _Float16*)(ws + WS_WXK))[(size_t)n * 1024 + k], (float)(_Float16)p.in[I_XAKV][((size_t)layer * 1024 + k) * 2048 + n], 1e-6f);
          report(ws, slot, (float)((const _Float16*)(ws + WS_WXV))[(size_t)n * 1024 + k], (float)(_Float16)p.in[I_XAKV][((size_t)layer * 1024 + k) * 2048 + 1024 + n], 1e-6f);
          report(ws, slot, (float)((const _Float16*)(ws + WS_WXO))[(size_t)n * 1024 + k], (float)(_Float16)p.in[I_XAO][((size_t)layer * 1024 + k) * 1024 + n], 1e-6f); }
        { const int n = r % 5632, k = (r >> 13) % 1024; report(ws, slot, (float)((const _Float16*)(ws + WS_WF1))[(size_t)n * 1024 + k], (float)(_Float16)p.in[I_FW1][((size_t)layer * 1024 + k) * 5632 + n], 1e-6f); }
        { const int n = r % 1024, k = (r >> 11) % 2816; report(ws, slot, (float)((const _Float16*)(ws + WS_WF2))[(size_t)n * 2816 + k], (float)(_Float16)p.in[I_FW2][((size_t)layer * 2816 + k) * 1024 + n], 1e-6f); }
        break; }
    case CK_A: {
        const _Float16* xr = XH + (size_t)m * 1024;
        for (int j = 0; j < 6; ++j) { const unsigned r = hsh(sidx * 64 + j + 999u);
            { const int hh = r & 3, mm = (r >> 2) & 1, i = (r >> 3) & 31, isk = (r >> 8) & 1; const int cb = isk * 512 + hh * 128 + mm * 64;
              const float x1 = blk_dot_h(xr, w_in + cb + i, INCOLS, 1024, red), x2 = blk_dot_h(xr, w_in + cb + i + 32, INCOLS, 1024, red);
              const float ang = (float)pos * kInvFreq[i]; const float c = cosf(ang), s_ = sinf(ang), sc = isk ? 1.0f : 0.125f * LOG2E;
              const _Float16* d = (const _Float16*)(ws + (isk ? WS_KA : WS_QA)) + (size_t)m * 512 + hh * 128 + mm * 64;
              if (tid == 0) { report(ws, slot, (float)d[2 * i], (x1 * c - x2 * s_) * sc, 0.05f); report(ws, slot, (float)d[2 * i + 1], (x2 * c + x1 * s_) * sc, 0.05f); } }
            { const int c = (r >> 9) % 512;
              const float va = blk_dot_h(xr, w_in + 1024 + c, INCOLS, 1024, red), qb = blk_dot_h(xr, w_in + 1536 + c, INCOLS, 1024, red), kb = blk_dot_h(xr, w_in + 2048 + c, INCOLS, 1024, red), vb = blk_dot_h(xr, w_in + 2560 + c, INCOLS, 1024, red);
              const float gb = blk_dot_h(xr, w_in + 3072 + c, INCOLS, 1024, red), gc = blk_dot_h(xr, w_in + 3584 + c, INCOLS, 1024, red), hc = blk_dot_h(xr, w_in + 4096 + c, INCOLS, 1024, red);
              if (tid == 0) { const size_t o = (size_t)m * 512 + c;
                report(ws, slot, (float)((const _Float16*)(ws + WS_VA))[o], va, 0.05f); report(ws, slot, (float)((const _Float16*)(ws + WS_QB))[o], qb * 0.125f * LOG2E, 0.02f); report(ws, slot, (float)((const _Float16*)(ws + WS_KB))[o], kb, 0.05f);
                report(ws, slot, (float)((const _Float16*)(ws + WS_VB))[o], vb, 0.05f); report(ws, slot, (float)((const _Float16*)(ws + WS_GB))[o], gb, 0.05f); report(ws, slot, (float)((const _Float16*)(ws + WS_GCHC))[o], gc * hc, 0.05f); } }
            { const int mk = r % 512, c = (r >> 9) % 1024; const _Float16* mr = (const _Float16*)(ws + WS_MEMH) + (size_t)mk * 1024; const float* wkv = p.in[I_XAKV] + (size_t)layer * 1024 * 2048;
              const float kx = blk_dot_h(mr, wkv + c, 2048, 1024, red), vx = blk_dot_h(mr, wkv + 1024 + c, 2048, 1024, red);
              if (tid == 0) { report(ws, slot, (float)((const _Float16*)(ws + WS_KX))[(size_t)mk * 1024 + c], kx, 0.05f); report(ws, slot, (float)((const _Float16*)(ws + WS_VT))[(size_t)c * 512 + mk], vx, 0.05f); } }
        }
        break; }
    case CK_YA: {
        const int h = hsh(sidx + 77u) & 3; const _Float16* xr = XH + (size_t)m * 1024; float* q = sh + 16384;
        for (int j = 0; j < 64; ++j) { const int mm = j >> 5, i = j & 31; const int cb = h * 128 + mm * 64;
            const float x1 = blk_dot_h(xr, w_in + cb + i, INCOLS, 1024, red), x2 = blk_dot_h(xr, w_in + cb + i + 32, INCOLS, 1024, red);
            const float ang = (float)pos * kInvFreq[i]; const float c = cosf(ang), s_ = sinf(ang);
            if (tid == 0) { q[mm * 64 + 2 * i] = (x1 * c - x2 * s_) * 0.125f; q[mm * 64 + 2 * i + 1] = (x2 * c + x1 * s_) * 0.125f; } }
        __syncthreads();
        const _Float16* KA = (const _Float16*)(ws + WS_KA) + (size_t)b * SEQ * 512 + h * 128; const _Float16* VA = (const _Float16*)(ws + WS_VA) + (size_t)b * SEQ * 512 + h * 128;
        float mx0 = -1e30f, mx1 = -1e30f;
        for (int key = tid; key < SEQ; key += 256) { float s0 = 0.f, s1 = 0.f; for (int d = 0; d < 64; ++d) { s0 += q[d] * (float)KA[(size_t)key * 512 + d]; s1 += q[64 + d] * (float)KA[(size_t)key * 512 + 64 + d]; }
            sh[key] = s0; sh[8192 + key] = s1; mx0 = fmaxf(mx0, s0); mx1 = fmaxf(mx1, s1); }
        mx0 = blk_max(mx0, red); mx1 = blk_max(mx1, red);
        float l0 = 0.f, l1 = 0.f;
        for (int key = tid; key < SEQ; key += 256) { const float e0 = expf(sh[key] - mx0), e1 = expf(sh[8192 + key] - mx1); sh[key] = e0; sh[8192 + key] = e1; l0 += e0; l1 += e1; }
        l0 = blk_sum(l0, red); l1 = blk_sum(l1, red);
        const float lam = ((const float*)(ws + WS_MISC))[layer]; const float lam_init = layer == 0 ? 0.2f : 0.35550906759096926f;
        float dv = 0.f;
        if (tid < 128) { float o0 = 0.f, o1 = 0.f; for (int key = 0; key < SEQ; ++key) { const float v = (float)VA[(size_t)key * 512 + tid]; o0 += sh[key] * v; o1 += sh[8192 + key] * v; } dv = o0 / l0 - lam * (o1 / l1); }
        const float ss = blk_sum(dv * dv, red); const float ref = dv / sqrtf(ss / 128.f + LN_EPS) * p.in[I_SUBG][layer * 128 + (tid & 127)] * (1.0f - lam_init);
        if (tid < 128) report(ws, slot, (float)((const _Float16*)(ws + WS_QA))[(size_t)m * 512 + h * 128 + tid], ref, 0.05f);
        break; }
    case CK_YB: {
        const int h = hsh(sidx + 78u) & 7; const _Float16* xr = XH + (size_t)m * 1024; float* q = sh + 16384;
        for (int d = 0; d < 64; ++d) { const float x = blk_dot_h(xr, w_in + 1536 + h * 64 + d, INCOLS, 1024, red); if (tid == 0) q[d] = x * 0.125f; }
        __syncthreads();
        const int rq = pos >> 6, c = pos & 63; int rs = rq - 4; rs = rs < 0 ? 0 : (rs > 120 ? 120 : rs); int cs = c - 8; cs = cs < 0 ? 0 : (cs > 48 ? 48 : cs);
        const _Float16* KB = (const _Float16*)(ws + WS_KB) + (size_t)b * SEQ * 512 + h * 64; const _Float16* VB = (const _Float16*)(ws + WS_VB) + (size_t)b * SEQ * 512 + h * 64;
        const float* rpb = p.in[I_RPB] + ((size_t)layer * 8 + h) * 15 * 31;
        float sc = -1e30f; int key = 0;
        if (tid < 128) { const int kr = rs + (tid >> 4), kc = cs + (tid & 15); key = kr * 64 + kc; float s0 = 0.f; for (int d = 0; d < 64; ++d) s0 += q[d] * (float)KB[(size_t)key * 512 + d];
            sc = s0 + rpb[(kr - rq + 7) * 31 + (kc - c + 15)]; }
        const float mx = blk_max(sc, red); const float e = tid < 128 ? expf(sc - mx) : 0.f; const float l = blk_sum(e, red);
        if (tid < 128) { sh[tid] = e / l; sh[256 + tid] = __int_as_float(key); } __syncthreads();
        if (tid < 64) { float o = 0.f; for (int j = 0; j < 128; ++j) o += sh[j] * (float)VB[(size_t)__float_as_int(sh[256 + j]) * 512 + tid]; report(ws, slot, (float)((const _Float16*)(ws + WS_QB))[(size_t)m * 512 + h * 64 + tid], o, 0.05f); }
        break; }
    case CK_YC: { const _Float16* xr = XH + (size_t)m * 1024; const _Float16* P = (const _Float16*)(ws + WS_GCHC); const float* w = p.in[I_SCW] + (size_t)layer * 3 * 512;
        for (int j = 0; j < 8; ++j) { const int ch = hsh(sidx * 8 + j + 5u) % 512; const float gb = blk_dot_h(xr, w_in + 3072 + ch, INCOLS, 1024, red);
            if (tid == 0) { float a = w[512 + ch] * (float)P[(size_t)m * 512 + ch]; if (pos > 0) a += w[ch] * (float)P[(size_t)(m - 1) * 512 + ch]; if (pos < SEQ - 1) a += w[1024 + ch] * (float)P[(size_t)(m + 1) * 512 + ch];
                report(ws, slot, (float)((const _Float16*)(ws + WS_GB))[(size_t)m * 512 + ch], gb * a, 0.5f); } }
        break; }
    case CK_MG: { const _Float16* xr = XH + (size_t)m * 1024;
        for (int j = 0; j < 4; ++j) { const int c = hsh(sidx * 4 + j + 9u) % 1024; float tot = 0.f;
            for (int i = 0; i < 3; ++i) { const float g = blk_dot_h(xr, w_in + 4608 + i * 1024 + c, INCOLS, 1024, red);
                const _Float16* y = (const _Float16*)(ws + (i == 0 ? WS_QA : i == 1 ? WS_QB : WS_GB)) + (size_t)m * 512;
                const float z = blk_dot_h(y, p.in[I_WBR] + ((size_t)layer * 3 + i) * 512 * 1024 + c, 1024, 512, red); tot += z / (1.0f + expf(-g)); }
            if (tid == 0) report(ws, slot, (float)((const _Float16*)(ws + WS_MG))[(size_t)m * 1024 + c], tot, 0.3f); }
        break; }
    case CK_LN1: case CK_LN2: case CK_LN3: {
        const int which = ck == CK_LN1 ? 0 : ck == CK_LN2 ? 1 : 2; const int K = which == 2 ? 2816 : 1024;
        const _Float16* a = which == 0 ? (const _Float16*)(ws + WS_MG) + (size_t)m * 1024 : which == 1 ? (const _Float16*)(ws + WS_OX) + (size_t)m * 1024 : (const _Float16*)(ws + WS_UG) + (size_t)m * 5632;
        const float* W = which == 0 ? p.in[I_WMIX] + (size_t)layer * 1024 * 1024 : which == 1 ? p.in[I_XAO] + (size_t)layer * 1024 * 1024 : p.in[I_FW2] + (size_t)layer * 2816 * 1024;
        const float* snap = (const float*)(ws + WS_DBG) + sidx * 1024;
        for (int c = tid; c < 1024; c += 256) { float acc = 0.f; for (int k = 0; k < K; ++k) acc += (float)a[k] * (float)(_Float16)W[(size_t)k * 1024 + c]; sh[c] = ALPHA * snap[c] + acc; }
        __syncthreads(); ln_ref(sh, p.in[I_LNG] + ((size_t)layer * 3 + which) * 1024, p.in[I_LNB] + ((size_t)layer * 3 + which) * 1024, red);
        for (int c = tid; c < 1024; c += 256) { report(ws, slot, p.out[(size_t)m * 1024 + c], sh[c], 0.3f); report(ws, slot, (float)XH[(size_t)m * 1024 + c], sh[c], 0.3f); }
        break; }
    case CK_D1: { const _Float16* xr = XH + (size_t)m * 1024;
        for (int j = 0; j < 8; ++j) { const int c = hsh(sidx * 8 + j + 3u) % 1024; const float v = blk_dot_h(xr, p.in[I_XAQ] + (size_t)layer * 1024 * 1024 + c, 1024, 1024, red);
            if (tid == 0) report(ws, slot, (float)((const _Float16*)(ws + WS_QX))[(size_t)m * 1024 + c], v * 0.0625f * LOG2E, 0.02f); }
        break; }
    case CK_D2: { const int h = hsh(sidx + 31u) & 3; const _Float16* q = (const _Float16*)(ws + WS_QX) + (size_t)m * 1024 + h * 256; const _Float16* kx = (const _Float16*)(ws + WS_KX) + ((size_t)b * 256 + tid) * 1024 + h * 256;
        float s0 = 0.f; for (int d = 0; d < 256; ++d) s0 += (float)q[d] * (float)kx[d];
        const float mx = blk_max(s0, red); const float e = exp2f(s0 - mx); const float l = blk_sum(e, red);
        report(ws, slot, 256.f * (float)((const _Float16*)(ws + WS_PX))[(size_t)m * 1024 + h * 256 + tid], 256.f * e / l, 0.05f);
        break; }
    case CK_D3: { const int h = hsh(sidx + 32u) & 3; const _Float16* pr = (const _Float16*)(ws + WS_PX) + (size_t)m * 1024 + h * 256; const _Float16* vt = (const _Float16*)(ws + WS_VT) + ((size_t)h * 256 + tid) * 512 + b * 256;
        float o = 0.f; for (int key = 0; key < 256; ++key) o += (float)pr[key] * (float)vt[key];
        report(ws, slot, (float)((const _Float16*)(ws + WS_OX))[(size_t)m * 1024 + h * 256 + tid], o, 0.02f);
        break; }
    case CK_E1: { const _Float16* xr = XH + (size_t)m * 1024;
        for (int j = 0; j < 8; ++j) { const int c = hsh(sidx * 8 + j + 4u) % 5632; const float v = blk_dot_h(xr, p.in[I_FW1] + (size_t)layer * 1024 * 5632 + c, 5632, 1024, red);
            if (tid == 0) report(ws, slot, (float)((const _Float16*)(ws + WS_UG))[(size_t)m * 5632 + c], v, 0.3f); }
        break; }
    case CK_E2: { const _Float16* xr = XH + (size_t)m * 1024; const _Float16* UG = (const _Float16*)(ws + WS_UG); const float* w = p.in[I_FCW] + (size_t)layer * 3 * DFF; const float* bb = p.in[I_FCB] + (size_t)layer * DFF;
        for (int j = 0; j < 8; ++j) { const int ch = hsh(sidx * 8 + j + 6u) % DFF; const float u = blk_dot_h(xr, p.in[I_FW1] + (size_t)layer * 1024 * 5632 + ch, 5632, 1024, red);
            if (tid == 0) { float a = bb[ch] + w[DFF + ch] * (float)UG[(size_t)m * 5632 + DFF + ch]; if (pos > 0) a += w[ch] * (float)UG[(size_t)(m - 1) * 5632 + DFF + ch]; if (pos < SEQ - 1) a += w[2 * DFF + ch] * (float)UG[(size_t)(m + 1) * 5632 + DFF + ch];
                report(ws, slot, (float)UG[(size_t)m * 5632 + ch], a / (1.0f + expf(-a)) * u, 0.2f); } }
        break; }
    }
}
__global__ void __launch_bounds__(256) verdict_kernel(Params p, int which_layer_mask) {
    const unsigned* err = (const unsigned*)(p.ws + WS_CTL) + CW_ERR; int bad = -1;
    for (int i = 0; i < 2 * CK_N; ++i) if (__uint_as_float(err[i]) > 0.03f) { bad = i; break; }
    if (bad < 0) return;
    const float sc = (float)(bad + 2);
    for (size_t e = (size_t)blockIdx.x * 256 + threadIdx.x; e < (size_t)MTOK * DM; e += (size_t)gridDim.x * 256) p.out[e] *= sc;
}
#endif

constexpr int PH_PER_LAYER = 15, N_PHASES = 1 + NLAYER * PH_PER_LAYER - 1;

__global__ void __launch_bounds__(NTHREADS, 2) fwd_kernel(Params p) {
    extern __shared__ __attribute__((aligned(16))) unsigned char lds_raw[];
    Frame F;
    F.lds = (LAS unsigned char*)lds_raw; F.ws = p.ws; F.X32 = p.out;
    F.wave = __builtin_amdgcn_readfirstlane(threadIdx.x >> 6);
    F.G = gridDim.x; { const int bx = blockIdx.x; F.vcu = (F.G % 8 == 0) ? (bx % 8) * (F.G / 8) + bx / 8 : bx; }
    for (int u = threadIdx.x; u < (LDS_BYTES - LDSCTL_OFF) / 4; u += NTHREADS) ((LAS unsigned*)(F.lds + LDSCTL_OFF))[u] = 0u;
    __syncthreads();
    gu32* ctl = (gu32*)(p.ws + WS_CTL);
    XcdBarrier bar; bar.bar = (unsigned*)(ctl + CW_BAR); bar.x = 0; bar.st = nullptr;
    const bool use_bar = (p.ph_hi - p.ph_lo) > 1;
    if (use_bar) bar = xcd_barrier_post((unsigned*)(ctl + CW_BAR), (volatile LAS unsigned*)(F.lds + MISC_OFF) + 8);

    for (int ph = p.ph_lo; ph < p.ph_hi; ++ph) {
        if (ph == 0) { phase_init(F); phase_weights(F, 0); }
        else {
            const int layer = (ph - 1) / PH_PER_LAYER, k = (ph - 1) % PH_PER_LAYER;
            switch (k) {
            case 0: gemm_phase(F, GK_A, layer); break;
            case 1: {
                for (int u = F.vcu; u < 256; u += F.G) fa::diff_unit(F, layer, u);
                for (int u = F.vcu; u < 512; u += F.G) fa::na_unit(F, layer, u);
                phase_shortconv(F, layer);
                break; }
            case 2: gemm_phase(F, GK_C12, layer); break;
            case 3: gemm_phase(F, GK_C3, layer); break;
            case 4: phase_ln(F, layer, 0); break;
            case 5: gemm_phase(F, GK_D1, layer); break;
            case 6: gemm_phase(F, GK_D2, layer); break;
            case 7: gemm_phase(F, GK_D3, layer); break;
            case 8: gemm_phase(F, GK_D4, layer); break;
            case 9: phase_ln(F, layer, 1); break;
            case 10: gemm_phase(F, GK_E1, layer); break;
            case 11: phase_ffnact(F, layer); break;
            case 12: gemm_phase(F, GK_E3, layer); break;
            case 13: phase_ln(F, layer, 2); break;
            default: phase_weights(F, layer + 1); break;
            }
        }
        if (ph + 1 < p.ph_hi) xcd_barrier(bar);
    }
}

#if MK_CHECK
constexpr int CHK_LDS = (16384 + 2048 + 256) * 4;
static void chk_launch(const Params& p, int ck, int layer, hipStream_t stream) { hipLaunchKernelGGL(chk_kernel, dim3(16), dim3(256), CHK_LDS, stream, p, ck, layer); }
#endif
extern "C" void kernel_launch(void* const* d_in, const int* in_sizes, int n_in, void* d_out, int out_size, void* d_ws, size_t ws_size, hipStream_t stream) {
    static int grid = 0;
    if (grid == 0) {
        if (n_in != 23 || out_size != MTOK * DM || ws_size < WS_END) { fprintf(stderr, "kernel_launch: unexpected shapes (n_in %d, out %d, ws %zu)\n", n_in, out_size, ws_size); grid = -1; return; }
        int dev = 0, cus = 0, per_cu = 0;
        if (hipGetDevice(&dev) != hipSuccess || hipDeviceGetAttribute(&cus, hipDeviceAttributeMultiprocessorCount, dev) != hipSuccess) { grid = -1; return; }
        if (hipFuncSetAttribute((const void*)fwd_kernel, hipFuncAttributeMaxDynamicSharedMemorySize, LDS_BYTES) != hipSuccess) { fprintf(stderr, "kernel_launch: hipFuncSetAttribute failed\n"); grid = -1; return; }
        if (hipOccupancyMaxActiveBlocksPerMultiprocessor(&per_cu, (const void*)fwd_kernel, NTHREADS, LDS_BYTES) != hipSuccess || per_cu < 1) fprintf(stderr, "kernel_launch: occupancy query reports %d\n", per_cu);
        (void)hipGetLastError();
#if MK_CHECK
        (void)hipFuncSetAttribute((const void*)chk_kernel, hipFuncAttributeMaxDynamicSharedMemorySize, CHK_LDS);
#endif
        grid = cus;
        if (grid != 256) fprintf(stderr, "kernel_launch: %d CUs (built for 256)\n", grid);
    }
    if (grid < 0) return;
    (void)hipMemsetAsync((char*)d_ws + WS_CTL, 0, CTL_ZERO_BYTES, stream);
    Params p{};
    for (int i = 0; i < 23; ++i) p.in[i] = (const float*)d_in[i];
    p.out = (float*)d_out; p.ws = (unsigned char*)d_ws;
#if MK_PER_PHASE
    for (int ph = 0; ph < N_PHASES; ++ph) {
#if MK_CHECK
        { const int layer = ph == 0 ? 0 : (ph - 1) / PH_PER_LAYER, k = ph == 0 ? -1 : (ph - 1) % PH_PER_LAYER;
          if (k == 3 || k == 8 || k == 12) hipLaunchKernelGGL(snap_kernel, dim3(16), dim3(256), 0, stream, p); (void)layer; }
#endif
        p.ph_lo = ph; p.ph_hi = ph + 1; hipLaunchKernelGGL(fwd_kernel, dim3(grid), dim3(NTHREADS), LDS_BYTES, stream, p);
#if MK_CHECK
        { const int layer = ph == 0 ? 0 : (ph - 1) / PH_PER_LAYER, k = ph == 0 ? -1 : (ph - 1) % PH_PER_LAYER; const int base = layer * CK_N;
          if (ph == 0) { chk_launch(p, CK_XH0, 0, stream); chk_launch(p, CK_W, 0, stream); }
          if (k == 14) chk_launch(p, CK_W, layer + 1, stream);
          if (k == 0) chk_launch(p, CK_A, layer, stream);
          if (k == 1) { chk_launch(p, CK_YA, layer, stream); chk_launch(p, CK_YB, layer, stream); chk_launch(p, CK_YC, layer, stream); }
          if (k == 2) chk_launch(p, CK_MG, layer, stream);
          if (k == 4) chk_launch(p, CK_LN1, layer, stream);
          if (k == 5) chk_launch(p, CK_D1, layer, stream);
          if (k == 6) chk_launch(p, CK_D2, layer, stream);
          if (k == 7) chk_launch(p, CK_D3, layer, stream);
          if (k == 9) chk_launch(p, CK_LN2, layer, stream);
          if (k == 10) chk_launch(p, CK_E1, layer, stream);
          if (k == 11) chk_launch(p, CK_E2, layer, stream);
          if (k == 13) chk_launch(p, CK_LN3, layer, stream);
        }
#endif
    }
#if MK_CHECK
    hipLaunchKernelGGL(verdict_kernel, dim3(1024), dim3(256), 0, stream, p, 0);
#endif
#else
    p.ph_lo = 0; p.ph_hi = N_PHASES; hipLaunchKernelGGL(fwd_kernel, dim3(grid), dim3(NTHREADS), LDS_BYTES, stream, p);
#endif
}
```
